# Optimizing an MI355X kernel written in HIP

```python
import math
import jax, jax.numpy as jnp
from jax import lax
import numpy as np

D_MODEL = 2048
BATCH = 2
SEQ = 16384
DEPTH = 1

SB_HEADS = 8
SB_HEAD_DIM = D_MODEL // 16
SB_WIDTH = SB_HEADS * SB_HEAD_DIM
Q_BLOCK = 128
GM_GROUPS = 8
GM_GROUP_DIM = D_MODEL // 16
GM_WIDTH = GM_GROUPS * GM_GROUP_DIM
GM_CHUNK = 128
IN_WIDTH = 3 * SB_WIDTH + 2 * GM_WIDTH + 2 * D_MODEL
N_MEM = 256
X_HEADS = 4
X_HEAD_DIM = D_MODEL // 16
X_WIDTH = X_HEADS * X_HEAD_DIM
N_GROUPS = 4
EXPERTS_PER_GROUP = 8
N_EXPERTS = N_GROUPS * EXPERTS_PER_GROUP
TOP_K = 2
D_EXPERT = D_MODEL // 2
MOE_BLOCK = 128
EPS = 1e-6

kernel_name = "hybrid_stickbreak_gmlp_hmoe"


def rmsnorm(x, g):
    xf = x.astype(jnp.float32)
    y = xf * lax.rsqrt(jnp.mean(xf * xf, axis=-1, keepdims=True) + EPS)
    return (y * g.astype(jnp.float32)).astype(x.dtype)


def stick_breaking_attention(q, k, v):
    B, S, H, Dh = q.shape
    nb = S // Q_BLOCK
    scale = 1.0 / math.sqrt(Dh)
    kh = k.transpose(0, 2, 1, 3)
    vh = v.transpose(0, 2, 1, 3)
    qb = q.reshape(B, nb, Q_BLOCK, H, Dh).transpose(1, 0, 3, 2, 4)
    key_pos = jnp.arange(S)

    def one_block(args):
        q_i, i = args
        z = jnp.einsum('bhqd,bhkd->bhqk', q_i, kh, preferred_element_type=jnp.float32) * scale
        q_pos = i * Q_BLOCK + jnp.arange(Q_BLOCK)
        strict = key_pos[None, :] < q_pos[:, None]
        log_not = jnp.where(strict, jax.nn.log_sigmoid(-z), 0.0)
        between = lax.cumsum(log_not, axis=3, reverse=True) - log_not
        a = jnp.where(strict, jnp.exp(jax.nn.log_sigmoid(z) + between), 0.0)
        return jnp.einsum('bhqk,bhkd->bhqd', a.astype(vh.dtype), vh)

    o = lax.map(one_block, (qb, jnp.arange(nb)))
    return o.transpose(1, 0, 3, 2, 4).reshape(B, S, H * Dh)


def chunked_spatial_gating(u, v, g_norm, w_s, b_s):
    B, S, W = u.shape
    nc = S // GM_CHUNK
    v = rmsnorm(v, g_norm)
    vg = v.reshape(B, nc, GM_CHUNK, GM_GROUPS, GM_GROUP_DIM)
    mask = jnp.tril(jnp.ones((GM_CHUNK, GM_CHUNK), dtype=w_s.dtype))
    w = (w_s * mask[None]).astype(v.dtype)
    mixed = jnp.einsum('gts,bcsge->bctge', w, vg) + b_s.T.astype(v.dtype)[None, None, :, :, None]
    return u * mixed.reshape(B, S, W)


def memory_cross_attention(h, mem, w_xq, w_xkv, w_xo):
    B, S, _ = h.shape
    M = mem.shape[1]
    q = (h @ w_xq).reshape(B, S, X_HEADS, X_HEAD_DIM)
    k, v = jnp.split(mem @ w_xkv, 2, axis=-1)
    k = k.reshape(B, M, X_HEADS, X_HEAD_DIM)
    v = v.reshape(B, M, X_HEADS, X_HEAD_DIM)
    s = jnp.einsum('bqhd,bmhd->bhqm', q, k, preferred_element_type=jnp.float32) / math.sqrt(X_HEAD_DIM)
    p = jax.nn.softmax(s, axis=-1)
    o = jnp.einsum('bhqm,bmhd->bqhd', p.astype(v.dtype), v).reshape(B, S, X_WIDTH)
    return o @ w_xo


def hierarchical_moe(h, w_rg, b_rg, w_re, b_re, w_gate, w_up, w_down):
    B, S, D = h.shape
    T = B * S
    hf = h.reshape(T, D)
    g_logits = (hf @ w_rg).astype(jnp.float32) + b_rg.astype(jnp.float32)
    g_prob = jax.nn.softmax(g_logits, axis=-1)
    g_idx = jnp.argmax(g_logits, axis=-1).astype(jnp.int32)
    p_g = jnp.take_along_axis(g_prob, g_idx[:, None], axis=1)[:, 0]
    e_all = (hf @ w_re).astype(jnp.float32) + b_re.astype(jnp.float32)
    e_logits = jnp.take_along_axis(e_all.reshape(T, N_GROUPS, EXPERTS_PER_GROUP), g_idx[:, None, None], axis=1)[:, 0]
    top_v, top_i = lax.top_k(e_logits, TOP_K)
    weights = p_g[:, None] * jax.nn.softmax(top_v, axis=-1)
    expert = g_idx[:, None] * EXPERTS_PER_GROUP + top_i.astype(jnp.int32)
    n = T * TOP_K
    flat_e = expert.reshape(n)
    flat_tok = jnp.repeat(jnp.arange(T, dtype=jnp.int32), TOP_K)
    flat_w = weights.reshape(n)
    order = jnp.argsort(flat_e)
    sorted_e = flat_e[order]
    counts = jnp.bincount(flat_e, length=N_EXPERTS)
    padded = ((counts + MOE_BLOCK - 1) // MOE_BLOCK) * MOE_BLOCK
    starts = jnp.cumsum(counts) - counts
    pends = jnp.cumsum(padded)
    pstarts = pends - padded
    dest = pstarts[sorted_e] + jnp.arange(n) - starts[sorted_e]
    P = (-(-n // MOE_BLOCK) + N_EXPERTS) * MOE_BLOCK
    tok_buf = jnp.zeros((P,), jnp.int32).at[dest].set(flat_tok[order])
    w_buf = jnp.zeros((P,), jnp.float32).at[dest].set(flat_w[order])
    nblk = P // MOE_BLOCK
    blk_start = jnp.arange(nblk) * MOE_BLOCK
    blk_e = jnp.minimum(jnp.sum(pends[None, :] <= blk_start[:, None], axis=1), N_EXPERTS - 1)

    def run_block(args):
        tok, wt, e = args
        xb = hf[tok]
        y = (jax.nn.silu(xb @ w_gate[e]) * (xb @ w_up[e])) @ w_down[e]
        return y * wt[:, None].astype(y.dtype)

    ys = lax.map(run_block, (tok_buf.reshape(nblk, MOE_BLOCK), w_buf.reshape(nblk, MOE_BLOCK), blk_e))
    out = jnp.zeros((T, D), h.dtype).at[tok_buf].add(ys.reshape(P, D))
    return out.reshape(B, S, D)


def setup_inputs(seed: int = 0) -> dict:
    key = jax.random.key(seed)
    ks = jax.random.split(key, 24)
    f32 = jnp.float32
    L, D = DEPTH, D_MODEL

    def nrm(k, shape, fan_in):
        return jax.random.normal(k, shape, f32) * (fan_in ** -0.5)

    def gain(k, shape):
        return 1.0 + 0.02 * jax.random.normal(k, shape, f32)

    return {
        "x": jax.random.normal(ks[0], (BATCH, SEQ, D), f32),
        "mem": jax.random.normal(ks[1], (BATCH, N_MEM, D), f32),
        "g_mix": gain(ks[2], (L, D)),
        "w_in": nrm(ks[3], (L, D, IN_WIDTH), D),
        "g_gm": gain(ks[4], (L, GM_WIDTH)),
        "w_spatial": nrm(ks[5], (L, GM_GROUPS, GM_CHUNK, GM_CHUNK), GM_CHUNK),
        "b_spatial": 1.0 + 0.1 * jax.random.normal(ks[6], (L, GM_GROUPS, GM_CHUNK), f32),
        "w_branch_sb": nrm(ks[7], (L, SB_WIDTH, D), SB_WIDTH),
        "w_branch_gm": nrm(ks[8], (L, GM_WIDTH, D), GM_WIDTH),
        "w_out": nrm(ks[9], (L, D, D), D),
        "g_cross": gain(ks[10], (L, D)),
        "g_mem": gain(ks[11], (L, D)),
        "w_xq": nrm(ks[12], (L, D, X_WIDTH), D),
        "w_xkv": nrm(ks[13], (L, D, 2 * X_WIDTH), D),
        "w_xo": nrm(ks[14], (L, X_WIDTH, D), X_WIDTH),
        "g_ffn": gain(ks[15], (L, D)),
        "w_rg": nrm(ks[16], (L, D, N_GROUPS), D),
        "b_rg": 0.01 * jax.random.normal(ks[17], (L, N_GROUPS), f32),
        "w_re": nrm(ks[18], (L, D, N_EXPERTS), D),
        "b_re": 0.01 * jax.random.normal(ks[19], (L, N_EXPERTS), f32),
        "w_e_gate": nrm(ks[20], (L, N_EXPERTS, D, D_EXPERT), D),
        "w_e_up": nrm(ks[21], (L, N_EXPERTS, D, D_EXPERT), D),
        "w_e_down": nrm(ks[22], (L, N_EXPERTS, D_EXPERT, D), D_EXPERT),
        "g_final": gain(ks[23], (D,)),
    }


def reference(x, mem, g_mix, w_in, g_gm, w_spatial, b_spatial, w_branch_sb, w_branch_gm, w_out,
              g_cross, g_mem, w_xq, w_xkv, w_xo, g_ffn, w_rg, b_rg, w_re, b_re,
              w_e_gate, w_e_up, w_e_down, g_final):
    B, S, D = x.shape
    splits = [SB_WIDTH, 2 * SB_WIDTH, 3 * SB_WIDTH, 3 * SB_WIDTH + GM_WIDTH,
              3 * SB_WIDTH + 2 * GM_WIDTH, 3 * SB_WIDTH + 2 * GM_WIDTH + D_MODEL]
    for l in range(DEPTH):
        hn = rmsnorm(x, g_mix[l])
        proj = hn @ w_in[l]
        q, k, v, u_gm, v_gm, gate_sb, gate_gm = jnp.split(proj, splits, axis=-1)
        o_sb = stick_breaking_attention(q.reshape(B, S, SB_HEADS, SB_HEAD_DIM),
                                        k.reshape(B, S, SB_HEADS, SB_HEAD_DIM),
                                        v.reshape(B, S, SB_HEADS, SB_HEAD_DIM))
        o_gm = chunked_spatial_gating(jax.nn.gelu(u_gm), jax.nn.gelu(v_gm),
                                      g_gm[l], w_spatial[l], b_spatial[l])
        merged = (jax.nn.sigmoid(gate_sb) * (o_sb @ w_branch_sb[l])
                  + jax.nn.sigmoid(gate_gm) * (o_gm @ w_branch_gm[l]))
        x = x + merged @ w_out[l]
        x = x + memory_cross_attention(rmsnorm(x, g_cross[l]), rmsnorm(mem, g_mem[l]),
                                       w_xq[l], w_xkv[l], w_xo[l])
        x = x + hierarchical_moe(rmsnorm(x, g_ffn[l]), w_rg[l], b_rg[l], w_re[l], b_re[l],
                                 w_e_gate[l], w_e_up[l], w_e_down[l])
    return rmsnorm(x, g_final)
```

```cpp
#include <hip/hip_runtime.h>
#include <cstdio>
#include <cstdint>

__device__ __forceinline__ int shx_lane_() { unsigned z = 0u; asm volatile("" : "+v"(z)); return (int)__builtin_amdgcn_mbcnt_hi(~0u, __builtin_amdgcn_mbcnt_lo(~0u, z)); }
__device__ __forceinline__ float shx_(float v, int m) { return __int_as_float(__builtin_amdgcn_ds_bpermute((shx_lane_() ^ m) << 2, __float_as_int(v))); }
__device__ __forceinline__ int shx_(int v, int m) { return __builtin_amdgcn_ds_bpermute((shx_lane_() ^ m) << 2, v); }
#define __shfl_xor(v, m) shx_((v), (m))

constexpr int BATCH = 2, SEQ = 16384, DM = 2048, T = BATCH * SEQ;
constexpr int LDP = 9216;
constexpr int PC_Q = 0, PC_K = 1024, PC_V = 2048, PC_U = 3072, PC_VG = 4096, PC_GS = 5120, PC_GG = 7168;
constexpr int NMEM = 256, NEXP = 32, CAP = 32768;
constexpr float EPS = 1e-6f;

namespace pg8 {
#define PG8_LAS __attribute__((address_space(3)))
typedef unsigned short bf16_t;
typedef short bf16x8 __attribute__((ext_vector_type(8)));
typedef float f32x4 __attribute__((ext_vector_type(4)));
typedef float f32x2 __attribute__((ext_vector_type(2)));
typedef unsigned u32x4 __attribute__((ext_vector_type(4)));
typedef long i64x2 __attribute__((ext_vector_type(2)));
typedef int i32x4 __attribute__((ext_vector_type(4)));
typedef int i32x8 __attribute__((ext_vector_type(8)));
typedef unsigned u32x2 __attribute__((ext_vector_type(2)));
constexpr int PG8_RS_OFF = 131072 + 2048 + 2048, PG8_SW_OFF = 131072 + 2048 + 4096;
constexpr int PG8_IDX_OFF = 131072 + 2048;
constexpr int BM = 256, BK = 64, HALF = 128, HTB = HALF * BK * 2  , STAGE_BYTES = 8 * HTB, NXCD = 8, WGM = 8;

__host__ __device__ __forceinline__ int lds_byte(int r, int c) { const int st = (r >> 4) * 2 + (c >> 5), rr = r & 15, cc = c & 31, ob = rr * 64 + cc * 2; return st * 1024 + (ob ^ (((ob >> 9) & 1) << 5)); }
__host__ __device__ __forceinline__ void stage_rc(int b, int& R, int& C) { const int st = b / 1024, sb = b % 1024, swz = sb ^ (((sb >> 9) & 1) << 5); R = (st >> 1) * 16 + swz / 64; C = (st & 1) * 32 + (swz % 64) / 2; }
__host__ __device__ __forceinline__ int perm32(int rho) { const int n = rho >> 4, i = rho & 15; return 8 * (i >> 2) + 4 * n + (i & 3); }

struct Unit { int pm, pn, e, lo, par; };
struct Gemm { const bf16_t* A; const bf16_t* Bt; int M, N, K; };

struct StaticOrder {
    int nM, nN, nwg, G, c, wgm;
    __host__ __device__ void init(int M, int N, int G_, int c_, int wgm_ = 2) { nM = M / BM; nN = N / BM; nwg = nM * nN; G = G_; c = c_; wgm = wgm_; }
    __host__ __device__ bool next(int i, Unit& u) const {
        const long L = (long)i * G + c; if (L >= nwg) return false;
        int wgid = (int)L; { const int q = nwg / NXCD, r = nwg % NXCD, xcd = wgid % NXCD, off = wgid / NXCD; wgid = (xcd < r ? xcd * (q + 1) : r * (q + 1) + (xcd - r) * q) + off; }
        const int nig = wgm * nN, gid = wgid / nig, fm = gid * wgm, gsz = (nM - fm) < wgm ? (nM - fm) : wgm;
        u.pm = fm + ((wgid % nig) % gsz); u.pn = (wgid % nig) / gsz; u.e = 0; u.lo = 0; return true;
    }
    __device__ __forceinline__ const char* aptr(const Gemm& g, const Unit& u) const { return (const char*)g.A + (size_t)u.pm * ((size_t)BM * g.K * 2); }
    __device__ __forceinline__ const char* bptr(const Gemm& g, const Unit& u) const { return (const char*)g.Bt + (size_t)u.pn * ((size_t)BM * g.K * 2); }
    __device__ __forceinline__ const int* arows(const Unit&) const { return nullptr; }
};
struct PairOrder {
    StaticOrder S; const bf16_t* A1; const bf16_t* B1;
    __device__ __forceinline__ bool next(int i, Unit& u) const { const bool ok = S.next(i >> 1, u); u.e = i & 1; return ok; }
    __device__ __forceinline__ const char* aptr(const Gemm& g, const Unit& u) const { return (const char*)(u.e ? A1 : g.A) + (size_t)u.pm * ((size_t)BM * g.K * 2); }
    __device__ __forceinline__ const char* bptr(const Gemm& g, const Unit& u) const { return (const char*)(u.e ? B1 : g.Bt) + (size_t)u.pn * ((size_t)BM * g.K * 2); }
    __device__ __forceinline__ const int* arows(const Unit&) const { return nullptr; }
};
struct MoeOrder {
    const PG8_LAS int* tb; int NT, G, c; const int* rows; size_t estride;
    __device__ __forceinline__ bool next(int i, Unit& u) const {
        const int L = i * G + c; if (L >= NT * 8) return false;
        const int tt = L >> 3; int e = 0;
#pragma unroll
        for (int k = 1; k < NEXP; ++k) e += (tb[k] <= tt) ? 1 : 0;
        e = __builtin_amdgcn_readfirstlane(e);
        const int tb_e = __builtin_amdgcn_readfirstlane(tb[e]);
        u.pm = tt; u.pn = L & 7; u.e = e; u.lo = e * CAP + (tt - tb_e) * BM; return true;
    }
    __device__ __forceinline__ const char* aptr(const Gemm& g, const Unit& u) const { return (const char*)g.A + (size_t)u.pm * ((size_t)BM * g.K * 2); }
    __device__ __forceinline__ const char* bptr(const Gemm& g, const Unit& u) const { return (const char*)g.Bt + (size_t)u.e * estride + (size_t)u.pn * ((size_t)BM * g.K * 2); }
    __device__ __forceinline__ const int* arows(const Unit& u) const { return rows + u.lo; }
};

__device__ __forceinline__ unsigned cvt_pk_bf16(float lo, float hi) { unsigned r; asm volatile("v_cvt_pk_bf16_f32 %0, %1, %2" : "=v"(r) : "v"(lo), "v"(hi)); return r; }
__device__ __forceinline__ float bf_lo(unsigned w) { return __uint_as_float(w << 16); }
__device__ __forceinline__ float bf_hi(unsigned w) { return __uint_as_float(w & 0xffff0000u); }
__device__ __forceinline__ float sigmoidf_(float x) { return __builtin_amdgcn_rcpf(1.0f + __builtin_amdgcn_exp2f(-1.4426950408889634f * x)); }
__device__ __forceinline__ float gelu_tanh(float x) { constexpr float GC1 = -2.0f * 0.7978845608028654f * 1.4426950408889634f, GC2 = 0.044715f * GC1;
    const float t = x * __builtin_fmaf(GC2, x * x, GC1); return x * __builtin_amdgcn_rcpf(1.0f + __builtin_amdgcn_exp2f(t)); }
__device__ __forceinline__ float sigmoid_pre(float zn) { return __builtin_amdgcn_rcpf(1.0f + __builtin_amdgcn_exp2f(zn)); }
__device__ __forceinline__ u32x4 pack8(const f32x4& a, const f32x4& b) { u32x4 w; w.x = cvt_pk_bf16(a[0], a[1]); w.y = cvt_pk_bf16(a[2], a[3]); w.z = cvt_pk_bf16(b[0], b[1]); w.w = cvt_pk_bf16(b[2], b[3]); return w; }

__device__ __forceinline__ unsigned pk_gate4(float a, float b, float c, float d) {
    const unsigned q0 = __float_as_uint(__builtin_fmaf(a, 255.f, 8388608.f)), q1 = __float_as_uint(__builtin_fmaf(b, 255.f, 8388608.f));
    const unsigned q2 = __float_as_uint(__builtin_fmaf(c, 255.f, 8388608.f)), q3 = __float_as_uint(__builtin_fmaf(d, 255.f, 8388608.f));
    return __builtin_amdgcn_perm(q1, q0, 0x0c0c0400u) | __builtin_amdgcn_perm(q3, q2, 0x04000c0cu); }
__device__ __forceinline__ float gate_b(unsigned w, int k) { return (float)((w >> (8 * k)) & 0xffu) * (1.0f / 255.0f); }
__device__ __forceinline__ float gate_q(unsigned w, int k) { return (float)((w >> (8 * k)) & 0xffu); }
constexpr int GATE_BYTE_OFF = 5120 * 2;
__device__ __forceinline__ unsigned pk_fp8x4(float a, float b, float c, float d) {
    a = __builtin_amdgcn_fmed3f(a, -448.f, 448.f); b = __builtin_amdgcn_fmed3f(b, -448.f, 448.f); c = __builtin_amdgcn_fmed3f(c, -448.f, 448.f); d = __builtin_amdgcn_fmed3f(d, -448.f, 448.f);
    int p = __builtin_amdgcn_cvt_pk_fp8_f32(a, b, 0, false); p = __builtin_amdgcn_cvt_pk_fp8_f32(c, d, p, true); return (unsigned)p; }
#define EPI_ROWS_BEGIN _Pragma("unroll") for (int ai = 0; ai < 2; ++ai) _Pragma("unroll") for (int m = 0; m < 4; ++m) {
#define EPI_ROWS_END }

struct EpiIn {
    static constexpr bool PERM = true;
    bf16_t* O; float* ssv;
    __device__ __forceinline__ void operator()(const f32x4 (&acc)[2][2][4][2], const Unit& u, int wr, int wc, int fr, int fq) const {
        const int pn = u.pn, mode = pn < 12 ? 0 : 1;
        const int row0 = u.pm * BM + wr * 64 + fr, col0 = pn * BM + wc * 32 + 8 * fq;
        EPI_ROWS_BEGIN
            const int row = row0 + ai * HALF + m * 16; bf16_t* rowp = O + (size_t)row * LDP + col0; float ss = 0.f;
#pragma unroll
            for (int bj = 0; bj < 2; ++bj) { f32x4 v0 = acc[ai][bj][m][0], v1 = acc[ai][bj][m][1];
                if (mode == 1) {
#pragma unroll
                    for (int k = 0; k < 4; ++k) { v0[k] = gelu_tanh(v0[k]); v1[k] = gelu_tanh(v1[k]); ss += v0[k] * v0[k] + v1[k] * v1[k]; }
                }
                *(u32x4*)(rowp + bj * HALF) = pack8(v0, v1); }
            if (pn >= 16 && pn < 20) { ss += __shfl_xor(ss, 16); ss += __shfl_xor(ss, 32); if (fq == 0) ssv[(size_t)row * 16 + (pn - 16) * 4 + wc] = ss; }
        EPI_ROWS_END
    }
};
struct EpiGateQ {
    static constexpr bool PERM = true;
    bf16_t* O;
    __device__ __forceinline__ void operator()(const f32x4 (&acc)[2][2][4][2], const Unit& u, int wr, int wc, int fr, int fq) const {
        int t_ = threadIdx.x; asm volatile("" : "+v"(t_));
        { const int wid_ = t_ >> 6, lane_ = t_ & 63; wr = wid_ >> 2; wc = wid_ & 3; fr = lane_ & 15; fq = lane_ >> 4; }
        const int row0 = u.pm * BM + wr * 64 + fr, colg = u.pn * BM + wc * 32 + 8 * fq;
        EPI_ROWS_BEGIN
            unsigned char* gp = (unsigned char*)(O + (size_t)(row0 + ai * HALF + m * 16) * LDP) + GATE_BYTE_OFF + colg;
#pragma unroll
            for (int bj = 0; bj < 2; ++bj) { f32x4 v0 = acc[ai][bj][m][0], v1 = acc[ai][bj][m][1];
#pragma unroll
                for (int k = 0; k < 4; ++k) { v0[k] = sigmoid_pre(v0[k]); v1[k] = sigmoid_pre(v1[k]); }
                u32x2 q8; q8.x = pk_gate4(v0[0], v0[1], v0[2], v0[3]); q8.y = pk_gate4(v1[0], v1[1], v1[2], v1[3]);
                *(u32x2*)(gp + bj * HALF) = q8; }
        EPI_ROWS_END
    }
};
struct EpiPlain {
    static constexpr bool PERM = true;
    bf16_t* O; int ldc;
    __device__ __forceinline__ void operator()(const f32x4 (&acc)[2][2][4][2], const Unit& u, int wr, int wc, int fr, int fq) const {
        const int row0 = u.pm * BM + wr * 64 + fr, col0 = u.pn * BM + wc * 32 + 8 * fq;
        EPI_ROWS_BEGIN
            bf16_t* rowp = O + (size_t)(row0 + ai * HALF + m * 16) * ldc + col0;
#pragma unroll
            for (int bj = 0; bj < 2; ++bj) *(u32x4*)(rowp + bj * HALF) = pack8(acc[ai][bj][m][0], acc[ai][bj][m][1]);
        EPI_ROWS_END
    }
};
__device__ __forceinline__ unsigned pg8_listoff() { int t_ = threadIdx.x; asm volatile("" : "+v"(t_)); return (unsigned)((t_ & 63) * 4 + ((t_ >> 6) & 3) * 256); }
template <class T> struct HasPre { static constexpr bool value = false; };
template <class T> struct KeepAcc { static __device__ __forceinline__ bool get(const Unit&) { return false; } };
__device__ __forceinline__ float gate_ratio(float a, float b) { return a * __builtin_amdgcn_rcpf(fmaxf(b, 1e-20f)); }
struct EpiGate3 {
    static constexpr bool PERM = true;
    const bf16_t* P; bf16_t* MG;
    __device__ __forceinline__ void operator()(f32x4 (&acc)[2][2][4][2], const Unit& u, int wr, int wc, int fr, int fq) const {
        const int row0 = u.pm * BM + wr * 64 + fr, col0 = u.pn * BM + wc * 32 + 8 * fq;
        if (u.e == 0) {
            u32x2 gs[2][4][2], gg[2][4][2];
#pragma unroll
            for (int ai = 0; ai < 2; ++ai)
#pragma unroll
                for (int m = 0; m < 4; ++m)
#pragma unroll
                    for (int bj = 0; bj < 2; ++bj) { const unsigned char* gp = (const unsigned char*)(P + (size_t)(row0 + ai * HALF + m * 16) * LDP) + GATE_BYTE_OFF + col0 + bj * HALF;
                        gs[ai][m][bj] = *(const u32x2*)gp; gg[ai][m][bj] = *(const u32x2*)(gp + 2048); }
#pragma unroll
            for (int ai = 0; ai < 2; ++ai)
#pragma unroll
                for (int m = 0; m < 4; ++m)
#pragma unroll
                    for (int bj = 0; bj < 2; ++bj) { const u32x2 a = gs[ai][m][bj], b = gg[ai][m][bj]; f32x4& v0 = acc[ai][bj][m][0]; f32x4& v1 = acc[ai][bj][m][1];
#pragma unroll
                        for (int k = 0; k < 4; ++k) { v0[k] *= gate_q(a.x, k) * __builtin_amdgcn_rcpf(fmaxf(gate_q(b.x, k), 255e-20f)); v1[k] *= gate_q(a.y, k) * __builtin_amdgcn_rcpf(fmaxf(gate_q(b.y, k), 255e-20f)); } }
        } else {
            u32x2 gg[2][4][2];
#pragma unroll
            for (int ai = 0; ai < 2; ++ai)
#pragma unroll
                for (int m = 0; m < 4; ++m)
#pragma unroll
                    for (int bj = 0; bj < 2; ++bj) gg[ai][m][bj] = *(const u32x2*)((const unsigned char*)(P + (size_t)(row0 + ai * HALF + m * 16) * LDP) + GATE_BYTE_OFF + 2048 + col0 + bj * HALF);
#pragma unroll
            for (int ai = 0; ai < 2; ++ai)
#pragma unroll
                for (int m = 0; m < 4; ++m)
#pragma unroll
                    for (int bj = 0; bj < 2; ++bj) { const u32x2 b = gg[ai][m][bj]; f32x4 v0 = acc[ai][bj][m][0], v1 = acc[ai][bj][m][1];
#pragma unroll
                        for (int k = 0; k < 4; ++k) { v0[k] *= fmaxf(gate_b(b.x, k), 1e-20f); v1[k] *= fmaxf(gate_b(b.y, k), 1e-20f); }
                        *(u32x4*)(MG + (size_t)(row0 + ai * HALF + m * 16) * DM + col0 + bj * HALF) = pack8(v0, v1); }
        }
    }
};
template <> struct KeepAcc<EpiGate3> { static __device__ __forceinline__ bool get(const Unit& u) { return u.e == 0; } };
struct EpiRes {
    static constexpr bool PERM = true;
    const bf16_t* XN; const float* XINV; bf16_t* XB; float* SS;
    __device__ __forceinline__ void operator()(const f32x4 (&acc)[2][2][4][2], const Unit& u, int wr, int wc, int fr, int fq) const {
        const int row0 = u.pm * BM + wr * 64 + fr, col0 = u.pn * BM + wc * 32 + 8 * fq;
        u32x4 xv[2][4][2]; float iv[2][4];
#pragma unroll
        for (int ai = 0; ai < 2; ++ai)
#pragma unroll
            for (int m = 0; m < 4; ++m) { const int row = row0 + ai * HALF + m * 16; iv[ai][m] = XINV[row];
#pragma unroll
                for (int bj = 0; bj < 2; ++bj) xv[ai][m][bj] = *(const u32x4*)(XN + (size_t)row * DM + col0 + bj * HALF); }
#pragma unroll
        for (int ai = 0; ai < 2; ++ai)
#pragma unroll
            for (int m = 0; m < 4; ++m) { const int row = row0 + ai * HALF + m * 16; float ss = 0.f; const float sc = iv[ai][m];
#pragma unroll
                for (int bj = 0; bj < 2; ++bj) { const size_t off = (size_t)row * DM + col0 + bj * HALF; const u32x4 p = xv[ai][m][bj];
                    f32x4 v0 = acc[ai][bj][m][0], v1 = acc[ai][bj][m][1];
                    v0[0] += bf_lo(p.x) * sc; v0[1] += bf_hi(p.x) * sc; v0[2] += bf_lo(p.y) * sc; v0[3] += bf_hi(p.y) * sc;
                    v1[0] += bf_lo(p.z) * sc; v1[1] += bf_hi(p.z) * sc; v1[2] += bf_lo(p.w) * sc; v1[3] += bf_hi(p.w) * sc;
                    *(u32x4*)(XB + off) = pack8(v0, v1);
#pragma unroll
                    for (int k = 0; k < 4; ++k) ss += v0[k] * v0[k] + v1[k] * v1[k]; }
                ss += __shfl_xor(ss, 16); ss += __shfl_xor(ss, 32); if (fq == 0) SS[(size_t)row * 32 + u.pn * 4 + wc] = ss; }
    }
};
struct EpiResB {
    static constexpr bool PERM = true;
    const bf16_t* XI; bf16_t* XB; unsigned char* X8;
    __device__ __forceinline__ void operator()(const f32x4 (&acc)[2][2][4][2], const Unit& u, int wr, int wc, int fr, int fq) const {
        const int row0 = u.pm * BM + wr * 64 + fr, col0 = u.pn * BM + wc * 32 + 8 * fq;
        u32x4 p[2][4][2];
#pragma unroll
        for (int ai = 0; ai < 2; ++ai)
#pragma unroll
            for (int m = 0; m < 4; ++m)
#pragma unroll
                for (int bj = 0; bj < 2; ++bj) p[ai][m][bj] = *(const u32x4*)(XI + (size_t)(row0 + ai * HALF + m * 16) * DM + col0 + bj * HALF);
#pragma unroll
        for (int ai = 0; ai < 2; ++ai)
#pragma unroll
            for (int m = 0; m < 4; ++m)
#pragma unroll
                for (int bj = 0; bj < 2; ++bj) { const size_t off = (size_t)(row0 + ai * HALF + m * 16) * DM + col0 + bj * HALF; const u32x4 pp = p[ai][m][bj];
                    f32x4 v0 = acc[ai][bj][m][0], v1 = acc[ai][bj][m][1];
                    v0[0] += bf_lo(pp.x); v0[1] += bf_hi(pp.x); v0[2] += bf_lo(pp.y); v0[3] += bf_hi(pp.y);
                    v1[0] += bf_lo(pp.z); v1[1] += bf_hi(pp.z); v1[2] += bf_lo(pp.w); v1[3] += bf_hi(pp.w);
                    *(u32x4*)(XB + off) = pack8(v0, v1);
                    u32x2 q8; q8.x = pk_fp8x4(v0[0], v0[1], v0[2], v0[3]); q8.y = pk_fp8x4(v1[0], v1[1], v1[2], v1[3]); *(u32x2*)(X8 + off) = q8; }
    }
};
struct EpiRowScale {
    static constexpr bool PERM = true;
    const float* SS; bf16_t* O; int ldc;
    __device__ __forceinline__ void operator()(const f32x4 (&acc)[2][2][4][2], const Unit& u, int wr, int wc, int fr, int fq) const {
        const int row0 = u.pm * BM + wr * 64 + fr, col0 = u.pn * BM + wc * 32 + 8 * fq;
#pragma unroll
        for (int ai = 0; ai < 2; ++ai) {
            f32x4 sp[4][2];
#pragma unroll
            for (int m = 0; m < 4; ++m) { const f32x4* p = (const f32x4*)(SS + (size_t)(row0 + ai * HALF + m * 16) * 32) + 2 * fq; sp[m][0] = p[0]; sp[m][1] = p[1]; }
#pragma unroll
            for (int m = 0; m < 4; ++m) { const int row = row0 + ai * HALF + m * 16; const f32x4 s = sp[m][0] + sp[m][1];
                float t = (s[0] + s[1]) + (s[2] + s[3]); t += __shfl_xor(t, 16); t += __shfl_xor(t, 32);
                const float rs = __builtin_amdgcn_rsqf(t * (1.0f / DM) + EPS);
                bf16_t* rowp = O + (size_t)row * ldc + col0;
#pragma unroll
                for (int bj = 0; bj < 2; ++bj) *(u32x4*)(rowp + bj * HALF) = pack8(acc[ai][bj][m][0] * rs, acc[ai][bj][m][1] * rs); }
        }
    }
};
struct EpiSwiglu {
    static constexpr bool PERM = true;
    const float* rsl; unsigned char* H; PG8_LAS unsigned char* L;
    __device__ __forceinline__ void pre(const Unit& u, int wid, int lane) const {
        __builtin_amdgcn_raw_ptr_buffer_load_lds(__builtin_amdgcn_make_buffer_rsrc((void*)rsl, (short)0, 0x7fffffff, 0x00020000), (PG8_LAS void*)(L + PG8_RS_OFF + u.par * 1024 + (wid & 3) * 256), 4,
                                                  pg8_listoff(), (unsigned)u.lo * 4u, 0, 0); }
    __device__ __forceinline__ void operator()(const f32x4 (&acc)[2][2][4][2], const Unit& u, int wr, int wc, int fr, int fq) const {
        int t_ = threadIdx.x; asm volatile("" : "+v"(t_));
        { const int wid_ = t_ >> 6, lane_ = t_ & 63; wr = wid_ >> 2; wc = wid_ & 3; fr = lane_ & 15; fq = lane_ >> 4; }
        const int r0 = wr * 64 + fr, col0 = u.pn * HALF + wc * 32 + 8 * fq;
        float rsv[2][4];
#pragma unroll
        for (int ai = 0; ai < 2; ++ai)
#pragma unroll
            for (int m = 0; m < 4; ++m) rsv[ai][m] = *(const PG8_LAS float*)(L + PG8_RS_OFF + u.par * 1024 + (r0 + ai * HALF + m * 16) * 4);
        EPI_ROWS_BEGIN
            const int rt = r0 + ai * HALF + m * 16; const float rs = rsv[ai][m];
            f32x4 g0 = acc[ai][0][m][0] * rs, g1 = acc[ai][0][m][1] * rs, u0 = acc[ai][1][m][0] * rs, u1 = acc[ai][1][m][1] * rs;
#pragma unroll
            for (int k = 0; k < 4; ++k) { g0[k] = g0[k] * sigmoidf_(g0[k]) * u0[k]; g1[k] = g1[k] * sigmoidf_(g1[k]) * u1[k]; }
            u32x2 q8; q8.x = pk_fp8x4(g0[0], g0[1], g0[2], g0[3]); q8.y = pk_fp8x4(g1[0], g1[1], g1[2], g1[3]); *(u32x2*)(H + (size_t)(u.pm * BM + rt) * 1024 + col0) = q8;
        EPI_ROWS_END
    }
};
struct EpiDown {
    static constexpr bool PERM = true;
    const int* slotl; const float* wl; unsigned char* Y; PG8_LAS unsigned char* L;
    __device__ __forceinline__ void pre(const Unit& u, int wid, int lane) const {
        const void* src_ = (wid < 4) ? (const void*)slotl : (const void*)wl;
        __builtin_amdgcn_raw_ptr_buffer_load_lds(__builtin_amdgcn_make_buffer_rsrc((void*)src_, (short)0, 0x7fffffff, 0x00020000), (PG8_LAS void*)(L + PG8_SW_OFF + u.par * 2048 + wid * 256), 4,
                                                  pg8_listoff(), (unsigned)u.lo * 4u, 0, 0); }
    __device__ __forceinline__ void operator()(const f32x4 (&acc)[2][2][4][2], const Unit& u, int wr, int wc, int fr, int fq) const {
        int t_ = threadIdx.x; asm volatile("" : "+v"(t_));
        { const int wid_ = t_ >> 6, lane_ = t_ & 63; wr = wid_ >> 2; wc = wid_ & 3; fr = lane_ & 15; fq = lane_ >> 4; }
        const int r0 = wr * 64 + fr, col0 = u.pn * BM + wc * 32 + 8 * fq;
        int slv[2][4]; float wv[2][4];
#pragma unroll
        for (int ai = 0; ai < 2; ++ai)
#pragma unroll
            for (int m = 0; m < 4; ++m) { const PG8_LAS unsigned char* p_ = L + PG8_SW_OFF + u.par * 2048 + (r0 + ai * HALF + m * 16) * 4; slv[ai][m] = *(const PG8_LAS int*)p_; wv[ai][m] = *(const PG8_LAS float*)(p_ + 1024); }
        EPI_ROWS_BEGIN
            const int slot = slv[ai][m]; const float w = wv[ai][m];
            if (slot >= 0) { unsigned char* rowp = Y + (size_t)slot * DM + col0;
#pragma unroll
                for (int bj = 0; bj < 2; ++bj) { const f32x4 v0 = acc[ai][bj][m][0] * w, v1 = acc[ai][bj][m][1] * w;
                    u32x2 pk; pk.x = pk_fp8x4(v0[0], v0[1], v0[2], v0[3]); pk.y = pk_fp8x4(v1[0], v1[1], v1[2], v1[3]);
                    *(u32x2*)(rowp + bj * HALF) = pk; } }
        EPI_ROWS_END
    }
};

template <> struct HasPre<EpiSwiglu> { static constexpr bool value = true; };
template <> struct HasPre<EpiDown> { static constexpr bool value = true; };
__device__ __forceinline__ const char* pg8_uni(const char* p) { const unsigned long long v = (unsigned long long)p;
    return (const char*)(((unsigned long long)(unsigned)__builtin_amdgcn_readfirstlane((int)(v >> 32)) << 32) | (unsigned)__builtin_amdgcn_readfirstlane((int)v)); }
template <class Epi, class Sched, bool GATHER, bool F8 = false, int WFMT = 1, unsigned WSC = 0x7F7F7F7Fu>
__device__ __forceinline__ void gemm_phase(PG8_LAS unsigned char* lds, const Gemm g, const Sched& S, const Epi& E) {
    int tid_ = threadIdx.x; asm volatile("" : "+v"(tid_));
    const int tid = tid_, wid = __builtin_amdgcn_readfirstlane(tid >> 6), lane = tid & 63, wr = wid >> 2, wc = wid & 3, fr = lane & 15, fq = lane >> 4;
    const int K = g.K, nt = K / BK;
    unsigned voffA[2], voffB[2]; int rA[2]; unsigned cA2[2];
#pragma unroll
    for (int i = 0; i < 2; ++i) { int R, C; stage_rc(tid * 16 + i * 8192, R, C); const int Rb = Epi::PERM ? ((R & ~31) + perm32(R & 31)) : R;
        voffA[i] = (unsigned)(R * K + C) * 2u; voffB[i] = (unsigned)(Rb * K + C) * 2u; rA[i] = R; cA2[i] = (unsigned)C * 2u; }
    const size_t kstep = (size_t)(BK * 2);
    const char* const baseA = (const char*)g.A; const char* const baseB = (const char*)g.Bt;
    const __amdgpu_buffer_rsrc_t rsA = __builtin_amdgcn_make_buffer_rsrc((void*)g.A, (short)0, 0x7fffffff, 0x00020000), rsB = __builtin_amdgcn_make_buffer_rsrc((void*)g.Bt, (short)0, 0x7fffffff, 0x00020000);
    const size_t hstep = (size_t)HALF * K * 2;
    const unsigned ldsw = (unsigned)wid * 1024u;
    const int aoff = lds_byte(wr * 64 + fr, fq * 8), boff = lds_byte(wc * 32 + fr, fq * 8);
    unsigned vaC[2][2], vaN[2][2];
#define PG8_SA(b, h) (((b) * 2 + (h)) * HTB)
#define PG8_SB(b, h) ((4 + (b) * 2 + (h)) * HTB)
#define PG8_STAGE_R(bufoff, rs, basep, gbase, voff) do { const unsigned _so = (unsigned)__builtin_amdgcn_readfirstlane((int)(unsigned)((const char*)(gbase) - (basep))); _Pragma("unroll") for (int _i = 0; _i < 2; ++_i) \
        __builtin_amdgcn_raw_ptr_buffer_load_lds(rs, (PG8_LAS void*)(lds + (bufoff) + ldsw + _i * 8192), 16, (voff)[_i], _so, 0, 0); } while (0)
#define PG8_STAGE(bufoff, gbase, voff) PG8_STAGE_R(bufoff, rsB, baseB, gbase, voff)
#define PG8_STAGE_A(bufoff, h, abase, useNext) do { if constexpr (GATHER) { unsigned _v[2]; _v[0] = (useNext) ? vaN[h][0] : vaC[h][0]; _v[1] = (useNext) ? vaN[h][1] : vaC[h][1]; PG8_STAGE_R(bufoff, rsA, baseA, abase, _v); } \
        else { PG8_STAGE_R(bufoff, rsA, baseA, (abase) + (h) * hstep, voffA); } } while (0)
#define PG8_ROWS(rows, va) do { _Pragma("unroll") for (int _h = 0; _h < 2; ++_h) _Pragma("unroll") for (int _i = 0; _i < 2; ++_i) { const unsigned _t = (unsigned)(rows)[_h * HALF + rA[_i]]; va[_h][_i] = _t * (unsigned)(K * 2) + cA2[_i]; } } while (0)
#define PG8_IDX_DMA(un, par) __builtin_amdgcn_raw_ptr_buffer_load_lds(rsR, (PG8_LAS void*)(lds + PG8_IDX_OFF + (par) * 1024 + (wid & 3) * 256), 4, pg8_listoff(), (unsigned)(un).lo * 4u, 0, 0)
#define PG8_IDX_RD(va, par) do { _Pragma("unroll") for (int _h = 0; _h < 2; ++_h) _Pragma("unroll") for (int _i = 0; _i < 2; ++_i) { \
        const unsigned _t = *(const PG8_LAS unsigned*)(lds + PG8_IDX_OFF + (par) * 1024 + (_h * HALF + rA[_i]) * 4); va[_h][_i] = _t * (unsigned)(K * 2) + cA2[_i]; } } while (0)
#define PG8_LD8(p) __builtin_shufflevector(*(const PG8_LAS i32x4*)(p), *(const PG8_LAS i32x4*)((p) + 1024), 0, 1, 2, 3, 4, 5, 6, 7)
#define PG8_LDA(dst, b, h) do { if constexpr (F8) { _Pragma("unroll") for (int m = 0; m < 4; ++m) dst##8[m] = PG8_LD8(lds + PG8_SA(b, h) + aoff + m * 2048); } \
        else { _Pragma("unroll") for (int m = 0; m < 4; ++m) _Pragma("unroll") for (int k = 0; k < 2; ++k) dst[m][k] = *(const PG8_LAS bf16x8*)(lds + PG8_SA(b, h) + aoff + m * 2048 + k * 1024); } } while (0)
#define PG8_LDB(dst, b, h) do { if constexpr (F8) { _Pragma("unroll") for (int n = 0; n < 2; ++n) dst##8[n] = PG8_LD8(lds + PG8_SB(b, h) + boff + n * 2048); } \
        else { _Pragma("unroll") for (int n = 0; n < 2; ++n) _Pragma("unroll") for (int k = 0; k < 2; ++k) dst[n][k] = *(const PG8_LAS bf16x8*)(lds + PG8_SB(b, h) + boff + n * 2048 + k * 1024); } } while (0)
#define PG8_MMA(ai, bj, A_, B_) do { __builtin_amdgcn_s_setprio(1); _Pragma("unroll") for (int m = 0; m < 4; ++m) _Pragma("unroll") for (int n = 0; n < 2; ++n) { \
        if constexpr (F8) acc[ai][bj][m][n] = __builtin_amdgcn_mfma_scale_f32_16x16x128_f8f6f4(B_##8[n], A_##8[m], acc[ai][bj][m][n], WFMT  , 0  , 0, (int)WSC, 0, 0x7F7F7F7F); \
        else { _Pragma("unroll") for (int k = 0; k < 2; ++k) acc[ai][bj][m][n] = __builtin_amdgcn_mfma_f32_16x16x32_bf16(B_[n][k], A_[m][k], acc[ai][bj][m][n], 0, 0, 0); } } __builtin_amdgcn_s_setprio(0); } while (0)
#define PG8_WAIT_V(n) asm volatile("s_waitcnt vmcnt(" #n ")" ::: "memory")
#define PG8_WAIT_L(n) asm volatile("s_waitcnt lgkmcnt(" #n ")" ::: "memory")
#define PG8_BAR __builtin_amdgcn_s_barrier()
#define PG8_SCHED __builtin_amdgcn_sched_barrier(0)
    Unit cur, nxt; int ui = 0;
    if (!S.next(0, cur)) return;
    cur.par = 0;
    if constexpr (HasPre<Epi>::value) E.pre(cur, wid, lane);
    f32x4 acc[2][2][4][2];
#pragma unroll
    for (int a = 0; a < 2; ++a)
#pragma unroll
        for (int b = 0; b < 2; ++b)
#pragma unroll
            for (int m = 0; m < 4; ++m)
#pragma unroll
                for (int n = 0; n < 2; ++n) acc[a][b][m][n] = (f32x4){0.f, 0.f, 0.f, 0.f};
    bf16x8 At[4][2], B0[2][2], B1[2][2]; i32x8 At8[4], B08[2], B18[2];
    const char* cA = pg8_uni(GATHER ? (const char*)g.A : S.aptr(g, cur)); const char* cB = pg8_uni(S.bptr(g, cur));
    __amdgpu_buffer_rsrc_t rsR = rsA;
    if constexpr (GATHER) { const int* rows = S.arows(cur); PG8_ROWS(rows, vaC);
        rsR = __builtin_amdgcn_make_buffer_rsrc((void*)S.rows, (short)0, 0x7fffffff, 0x00020000);
        Unit n1_; if (S.next(1, n1_)) PG8_IDX_DMA(n1_, 1); }
    PG8_STAGE(PG8_SB(0, 0), cB, voffB); PG8_STAGE(PG8_SB(0, 1), cB + hstep, voffB); PG8_STAGE_A(PG8_SA(0, 0), 0, cA, false); PG8_STAGE_A(PG8_SA(0, 1), 1, cA, false);
    if (wr == 1) PG8_BAR;
    PG8_WAIT_V(2); PG8_BAR;
    PG8_STAGE(PG8_SB(1, 0), cB + kstep, voffB); PG8_STAGE_A(PG8_SA(1, 0), 0, cA + kstep, false); PG8_STAGE(PG8_SB(1, 1), cB + hstep + kstep, voffB);
    PG8_WAIT_V(6); PG8_BAR;
    for (;;) {
        const bool has_next = S.next(ui + 1, nxt);
        const char* nA = pg8_uni(GATHER ? cA : (has_next ? S.aptr(g, nxt) : cA)); const char* nB = pg8_uni(has_next ? S.bptr(g, nxt) : cB);
        if constexpr (GATHER) {
            if (has_next) { PG8_IDX_RD(vaN, (ui + 1) & 1); }
            else {
#pragma unroll
                for (int h = 0; h < 2; ++h) { vaN[h][0] = vaC[h][0]; vaN[h][1] = vaC[h][1]; } }
        }
        if constexpr (GATHER) { Unit n2_; if (S.next(ui + 2, n2_)) PG8_IDX_DMA(n2_, ui & 1); }
#pragma unroll 1
        for (int t = 0; t < nt; t += 2) {
            const bool last = (t == nt - 2);
            const char* a1 = cA + (size_t)(t + 1) * kstep;
            const char* a2 = last ? nA : cA + (size_t)(t + 2) * kstep; const char* b2 = last ? nB : cB + (size_t)(t + 2) * kstep;
            const char* a3 = a2 + kstep; const char* b3 = b2 + kstep;
            PG8_LDB(B0, 0, 0); PG8_LDB(B1, 0, 1); PG8_SCHED; PG8_LDA(At, 0, 0); PG8_STAGE_A(PG8_SA(1, 1), 1, a1, false);
            PG8_WAIT_V(8); PG8_WAIT_L(0); PG8_BAR; PG8_MMA(0, 0, At, B0); PG8_MMA(0, 1, At, B1); PG8_BAR; PG8_SCHED;
            PG8_LDA(At, 0, 1); PG8_STAGE(PG8_SB(0, 0), b2, voffB); PG8_STAGE(PG8_SB(0, 1), b2 + hstep, voffB); PG8_STAGE_A(PG8_SA(0, 0), 0, a2, last);
            PG8_WAIT_V(8); PG8_WAIT_L(0); PG8_BAR; PG8_MMA(1, 0, At, B0); PG8_MMA(1, 1, At, B1); PG8_BAR; PG8_SCHED;
            PG8_LDB(B0, 1, 0); PG8_LDB(B1, 1, 1); PG8_SCHED; PG8_LDA(At, 1, 0); PG8_STAGE_A(PG8_SA(0, 1), 1, a2, last);
            PG8_WAIT_V(8); PG8_WAIT_L(0); PG8_BAR; PG8_MMA(0, 0, At, B0); PG8_MMA(0, 1, At, B1); PG8_BAR; PG8_SCHED;
            PG8_LDA(At, 1, 1); PG8_STAGE(PG8_SB(1, 0), b3, voffB); PG8_STAGE(PG8_SB(1, 1), b3 + hstep, voffB); PG8_STAGE_A(PG8_SA(1, 0), 0, a3, last);
            PG8_WAIT_V(8); PG8_WAIT_L(0); PG8_BAR; PG8_MMA(1, 0, At, B0); PG8_MMA(1, 1, At, B1); PG8_BAR; PG8_SCHED;
        }
        if (wr == 0) PG8_BAR;
        E(acc, cur, wr, wc, fr, fq);
        if (!has_next) break;
        if (!KeepAcc<Epi>::get(cur)) {
#pragma unroll
        for (int a = 0; a < 2; ++a)
#pragma unroll
            for (int b = 0; b < 2; ++b)
#pragma unroll
                for (int m = 0; m < 4; ++m)
#pragma unroll
                    for (int n = 0; n < 2; ++n) acc[a][b][m][n] = (f32x4){0.f, 0.f, 0.f, 0.f};
        }
        cur = nxt; cA = nA; cB = nB; ++ui; cur.par = ui & 1;
        if constexpr (HasPre<Epi>::value) E.pre(cur, wid, lane);
        if constexpr (GATHER) {
#pragma unroll
            for (int h = 0; h < 2; ++h) { vaC[h][0] = vaN[h][0]; vaC[h][1] = vaN[h][1]; } }
        if (wr == 1) PG8_BAR;
    }
    PG8_WAIT_V(0);
    PG8_BAR;
#undef PG8_SA
#undef PG8_SB
#undef PG8_STAGE
#undef PG8_STAGE_R
#undef PG8_STAGE_A
#undef PG8_ROWS
#undef PG8_IDX_DMA
#undef PG8_IDX_RD
#undef PG8_LDA
#undef PG8_LD8
#undef PG8_LDB
#undef PG8_MMA
#undef PG8_WAIT_V
#undef PG8_WAIT_L
#undef PG8_BAR
#undef PG8_SCHED
}
}

namespace att {
typedef unsigned short bf16_t;
using bf16x8 = __attribute__((ext_vector_type(8))) short;
using s16x4  = __attribute__((ext_vector_type(4))) short;
using f32x16 = __attribute__((ext_vector_type(16))) float;
using f32x4  = __attribute__((ext_vector_type(4))) float;
using u32x4  = __attribute__((ext_vector_type(4))) unsigned;
#define KSWZ(row, colB) ((row) * 256 + ((colB) ^ (((row) & 7) << 4)))
#define SBAR() __builtin_amdgcn_sched_barrier(0)
__device__ __forceinline__ int crow(int r, int hi) { return (r & 3) + 8 * (r >> 2) + 4 * hi; }
__device__ __forceinline__ unsigned cvtpk(float lo, float hi) { unsigned r; asm volatile("v_cvt_pk_bf16_f32 %0, %1, %2" : "=v"(r) : "v"(lo), "v"(hi)); return r; }
__device__ __forceinline__ unsigned short f2bf(float f) { return (unsigned short)(cvtpk(f, 0.f) & 0xffffu); }
__device__ __forceinline__ float bf2f(unsigned short h) { return __uint_as_float((unsigned)h << 16); }
constexpr int SHM_V = 64 * 128 * 2, SHM_K = 64 * 128 * 2;

#define PK4(P, BASE, OUT) do { unsigned a0 = cvtpk(P[BASE + 0], P[BASE + 1]), a1 = cvtpk(P[BASE + 2], P[BASE + 3]);   \
    unsigned b0 = cvtpk(P[BASE + 4], P[BASE + 5]), b1 = cvtpk(P[BASE + 6], P[BASE + 7]);                              \
    auto r0 = __builtin_amdgcn_permlane32_swap(a0, b0, false, false); auto r1 = __builtin_amdgcn_permlane32_swap(a1, b1, false, false); \
    u32x4 w = {r0[0], r1[0], r0[1], r1[1]}; OUT = *reinterpret_cast<bf16x8*>(&w); } while (0)

__device__ __forceinline__ void qkt(f32x16& p0, f32x16& p1, const bf16_t* Ks, const bf16x8* qr, int r32, int hi) {
  p0 = f32x16{}; p1 = f32x16{};
#pragma unroll
  for (int d0 = 0; d0 < 8; ++d0) { int cb = (d0 * 16 + hi * 8) * 2;
    bf16x8 b0 = *reinterpret_cast<const bf16x8*>((const char*)Ks + KSWZ(r32, cb));
    bf16x8 b1 = *reinterpret_cast<const bf16x8*>((const char*)Ks + KSWZ(32 + r32, cb));
    p0 = __builtin_amdgcn_mfma_f32_32x32x16_bf16(b0, qr[d0], p0, 0, 0, 0);
    p1 = __builtin_amdgcn_mfma_f32_32x32x16_bf16(b1, qr[d0], p1, 0, 0, 0); }
}
__device__ __forceinline__ int v_st(int k, int c) { const int kk = (k & ~0xC) | ((k & 4) << 1) | ((k & 8) >> 1); return ((kk >> 3) * 4 + (c >> 5)) * 512 + ((kk & 7) * 32 + (c & 31)) * 2; }
__device__ __forceinline__ int v_rd_base(int lane) { return ((lane & 3) << 3) | (((lane >> 2) & 3) << 6) | (((lane >> 4) & 1) << 5) | (((lane >> 5) & 1) << 8); }
constexpr int v_rd_off(int d0, int ks, int half) { return d0 * 512 + ks * 4096 + half * 2048; }
template <int OFF> __device__ __forceinline__ s16x4 tr_read(int vb) {
  s16x4 r; asm volatile("ds_read_b64_tr_b16 %0, %1 offset:%2" : "=&v"(r) : "v"(vb), "i"(OFF) : "memory"); return r;
}
template <int D0> __device__ __forceinline__ void pv_one(f32x16& od, int vb, bf16x8 pa0, bf16x8 pa1, bf16x8 pa2, bf16x8 pa3) {
  const s16x4 l0 = tr_read<v_rd_off(D0, 0, 0)>(vb), h0 = tr_read<v_rd_off(D0, 0, 1)>(vb), l1 = tr_read<v_rd_off(D0, 1, 0)>(vb), h1 = tr_read<v_rd_off(D0, 1, 1)>(vb);
  const s16x4 l2 = tr_read<v_rd_off(D0, 2, 0)>(vb), h2 = tr_read<v_rd_off(D0, 2, 1)>(vb), l3 = tr_read<v_rd_off(D0, 3, 0)>(vb), h3 = tr_read<v_rd_off(D0, 3, 1)>(vb);
  asm volatile("s_waitcnt lgkmcnt(0)" ::: "memory"); SBAR();
#define PKV(L, H) (bf16x8){L[0], L[1], L[2], L[3], H[0], H[1], H[2], H[3]}
  od = __builtin_amdgcn_mfma_f32_32x32x16_bf16(pa0, PKV(l0, h0), od, 0, 0, 0);
  od = __builtin_amdgcn_mfma_f32_32x32x16_bf16(pa1, PKV(l1, h1), od, 0, 0, 0);
  od = __builtin_amdgcn_mfma_f32_32x32x16_bf16(pa2, PKV(l2, h2), od, 0, 0, 0);
  od = __builtin_amdgcn_mfma_f32_32x32x16_bf16(pa3, PKV(l3, h3), od, 0, 0, 0);
#undef PKV
}
__device__ __forceinline__ void pv_d0(f32x16* o, int vb, bf16x8 pa0, bf16x8 pa1, bf16x8 pa2, bf16x8 pa3) {
  pv_one<0>(o[0], vb, pa0, pa1, pa2, pa3); pv_one<1>(o[1], vb, pa0, pa1, pa2, pa3); pv_one<2>(o[2], vb, pa0, pa1, pa2, pa3); pv_one<3>(o[3], vb, pa0, pa1, pa2, pa3);
}
typedef __attribute__((address_space(3))) unsigned short lds_u16;
__device__ __forceinline__ void store_o_bf16(const f32x16* o, const float* rs, bf16_t* Ow, int ldo, int lane, lds_u16* stg) {
  const int r32 = lane & 31, hi = lane >> 5;
#pragma unroll
  for (int d0 = 0; d0 < 4; ++d0) {
#pragma unroll
    for (int r = 0; r < 16; ++r) stg[crow(r, hi) * 32 + r32] = f2bf(o[d0][r] * rs[r]);
    asm volatile("s_waitcnt lgkmcnt(0)" ::: "memory");
#pragma unroll
    for (int t = 0; t < 2; ++t) { const int c = lane + 64 * t, row = c >> 2, part = c & 3;
      const u32x4 v = *(const __attribute__((address_space(3))) u32x4*)(stg + row * 32 + part * 8);
      *(u32x4*)(Ow + (size_t)row * ldo + d0 * 32 + part * 8) = v; }
    asm volatile("s_waitcnt lgkmcnt(0)" ::: "memory");
  }
}

template <bool MASKED> __device__ __forceinline__ void sb_weights(f32x16& p0, f32x16& p1, float& CP, int dq, int hi) {
  constexpr float ZS = 0.08838834764831845f * 1.4426950408889634f;
  float om0[16], om1[16];
#pragma unroll
  for (int r = 0; r < 16; ++r) {
    { const float en = __builtin_amdgcn_exp2f(-fmaxf(p0[r] * ZS, -100.f)); const float be = __builtin_amdgcn_rcpf(1.0f + en); const float om = en * be;
      if (MASKED) { const bool valid = ((r & 3) + 8 * (r >> 2)) < dq; p0[r] = valid ? be : 0.f; om0[r] = valid ? om : 1.f; } else { p0[r] = be; om0[r] = om; } }
    { const float en = __builtin_amdgcn_exp2f(-fmaxf(p1[r] * ZS, -100.f)); const float be = __builtin_amdgcn_rcpf(1.0f + en); const float om = en * be;
      if (MASKED) { const bool valid = (32 + (r & 3) + 8 * (r >> 2)) < dq; p1[r] = valid ? be : 0.f; om1[r] = valid ? om : 1.f; } else { p1[r] = be; om1[r] = om; } }
  }
  float tg[8];
#pragma unroll
  for (int gi = 0; gi < 4; ++gi) {
    { const float e1 = om0[4 * gi + 2] * om0[4 * gi + 3], e0 = om0[4 * gi + 1] * e1; tg[gi] = om0[4 * gi] * e0; p0[4 * gi + 2] *= om0[4 * gi + 3]; p0[4 * gi + 1] *= e1; p0[4 * gi] *= e0; }
    { const float e1 = om1[4 * gi + 2] * om1[4 * gi + 3], e0 = om1[4 * gi + 1] * e1; tg[4 + gi] = om1[4 * gi] * e0; p1[4 * gi + 2] *= om1[4 * gi + 3]; p1[4 * gi + 1] *= e1; p1[4 * gi] *= e0; }
  }
  float offP[8]; float run = CP;
#pragma unroll
  for (int gi = 7; gi >= 0; --gi) {
    auto rr = __builtin_amdgcn_permlane32_swap(__float_as_uint(tg[gi]), __float_as_uint(tg[gi]), false, false);
    const float pt = hi ? __uint_as_float(rr[0]) : __uint_as_float(rr[1]);
    offP[gi] = hi ? run : run * pt;
    run *= tg[gi] * pt; }
  CP = run;
#pragma unroll
  for (int r = 0; r < 16; ++r) { p0[r] *= offP[r >> 2]; p1[r] *= offP[4 + (r >> 2)]; }
}

typedef __attribute__((address_space(3))) unsigned char lds_u8;
__device__ __forceinline__ void sb_unit(const bf16_t* __restrict__ P, bf16_t* __restrict__ OSB, int b, int hp, int qblk, char* lds, lds_u8* ldsL, volatile __attribute__((address_space(3))) int* flags, lds_u16* stg) {
  int tid_ = threadIdx.x; asm volatile("" : "+v"(tid_));
  const int tid = tid_, wid = __builtin_amdgcn_readfirstlane(tid >> 6), lane = tid & 63, r32 = lane & 31, hi = lane >> 5;
  const size_t rowbase = (size_t)b * SEQ; const int q0 = qblk * 128;
  const int hsel = wid >> 2, jw = wid & 3, h = 2 * hp + hsel;
  bf16x8 qr[8];
  const int ftile = wid >> 1, fhalf = wid & 1;
  const char* tsrc = (const char*)(P + rowbase * LDP + ((ftile >> 1) ? PC_V : PC_K) + (2 * hp + (ftile & 1)) * 128);
  unsigned soff[8];
#pragma unroll
  for (int i = 0; i < 8; ++i) { const int o = (fhalf * 8 + i) * 1024 + lane * 16;
    const int krow = o >> 8, kcolB = (o & 255) ^ ((krow & 7) << 4);
    const int sub = o >> 9, kk = (sub >> 2) * 8 + ((o & 511) >> 6), vc = (sub & 3) * 32 + (((o & 511) >> 1) & 31), vk = (kk & ~0xC) | ((kk & 4) << 1) | ((kk & 8) >> 1);
    soff[i] = (ftile >> 1) ? (unsigned)(vk * (LDP * 2) + vc * 2) : (unsigned)(krow * (LDP * 2) + kcolB); }
  const unsigned fdst = (unsigned)(ftile * 16384 + fhalf * 8192);
#define SB_DMA(stage, kt_) do { const char* src_ = tsrc + (size_t)(kt_) * (size_t)(64 * LDP * 2); \
    _Pragma("unroll") for (int i = 0; i < 8; ++i) __builtin_amdgcn_global_load_lds((const unsigned*)(src_ + soff[i]), (__attribute__((address_space(3))) unsigned*)(ldsL + (stage) * 65536 + fdst + i * 1024), 16, 0, 0); } while (0)
  f32x16 o[4] = {};
  float CP = 1.f; const int qpos = q0 + jw * 32 + r32; bool fin = false;
  int kt = qblk * 2 + 1, st = 0;
  SB_DMA(0, kt);
  { const bf16_t* Qw = P + (rowbase + q0 + jw * 32 + r32) * LDP + PC_Q + h * 128 + hi * 8;
#pragma unroll
    for (int d0 = 0; d0 < 8; ++d0) qr[d0] = *reinterpret_cast<const bf16x8*>(Qw + d0 * 16); }
  asm volatile("" :: "v"(qr[0]), "v"(qr[1]), "v"(qr[2]), "v"(qr[3]), "v"(qr[4]), "v"(qr[5]), "v"(qr[6]), "v"(qr[7]));
  for (int it = 0;; ++it) {
    if (it > 0) { int all = 1;
#pragma unroll
      for (int w = 0; w < 8; ++w) all &= flags[w];
      if (all) { asm volatile("s_waitcnt vmcnt(0)" ::: "memory"); break; } }
    if (kt > 0) { SB_DMA(st ^ 1, kt - 1); asm volatile("s_waitcnt vmcnt(8)" ::: "memory"); }
    else asm volatile("s_waitcnt vmcnt(0)" ::: "memory");
    __builtin_amdgcn_s_barrier();
    asm volatile("" ::: "memory");
    const int key0 = kt * 64;
    if (!fin && key0 < q0 + jw * 32 + 31) {
      const bf16_t* K_lds = (const bf16_t*)(lds + st * 65536 + hsel * 16384);
      const int vb0 = (int)(uintptr_t)(lds + st * 65536 + 32768 + hsel * 16384) + v_rd_base(lane);
      f32x16 p0, p1; qkt(p0, p1, K_lds, qr, r32, hi);
      if (key0 + 63 < q0 + jw * 32) sb_weights<false>(p0, p1, CP, 0, hi);
      else sb_weights<true>(p0, p1, CP, qpos - key0 - 4 * hi, hi);
      bf16x8 pa0, pa1, pa2, pa3;
      PK4(p0, 0, pa0); PK4(p0, 8, pa1); PK4(p1, 0, pa2); PK4(p1, 8, pa3);
      pv_d0(o, vb0, pa0, pa1, pa2, pa3);
      fin = __all(CP < 1.1754944e-38f);
    }
    if (lane == 0) flags[wid] = fin ? 1 : 0;
    asm volatile("s_waitcnt lgkmcnt(0)" ::: "memory");
    __builtin_amdgcn_s_barrier();
    asm volatile("" ::: "memory");
    if (kt == 0) break;
    --kt; st ^= 1;
  }
#undef SB_DMA
  float ones[16];
#pragma unroll
  for (int r = 0; r < 16; ++r) ones[r] = 1.0f;
  store_o_bf16(o, ones, OSB + (rowbase + q0 + jw * 32) * 1024 + h * 128, 1024, lane, stg + wid * 1024);
}

template <int D0> __device__ __forceinline__ void pv_one_t(f32x16& od, int vb, bf16x8 pa0, bf16x8 pa1, bf16x8 pa2, bf16x8 pa3) {
  const s16x4 l0 = tr_read<v_rd_off(D0, 0, 0)>(vb), h0 = tr_read<v_rd_off(D0, 0, 1)>(vb), l1 = tr_read<v_rd_off(D0, 1, 0)>(vb), h1 = tr_read<v_rd_off(D0, 1, 1)>(vb);
  const s16x4 l2 = tr_read<v_rd_off(D0, 2, 0)>(vb), h2 = tr_read<v_rd_off(D0, 2, 1)>(vb), l3 = tr_read<v_rd_off(D0, 3, 0)>(vb), h3 = tr_read<v_rd_off(D0, 3, 1)>(vb);
  asm volatile("s_waitcnt lgkmcnt(0)" ::: "memory"); SBAR();
#define PKV(L, H) (bf16x8){L[0], L[1], L[2], L[3], H[0], H[1], H[2], H[3]}
  od = __builtin_amdgcn_mfma_f32_32x32x16_bf16(PKV(l0, h0), pa0, od, 0, 0, 0);
  od = __builtin_amdgcn_mfma_f32_32x32x16_bf16(PKV(l1, h1), pa1, od, 0, 0, 0);
  od = __builtin_amdgcn_mfma_f32_32x32x16_bf16(PKV(l2, h2), pa2, od, 0, 0, 0);
  od = __builtin_amdgcn_mfma_f32_32x32x16_bf16(PKV(l3, h3), pa3, od, 0, 0, 0);
#undef PKV
}
__device__ __forceinline__ bf16x8 scale8(bf16x8 v, float f, f32x4 g0, f32x4 g1) {
  u32x4 w = *reinterpret_cast<u32x4*>(&v), o;
  o[0] = cvtpk(__uint_as_float(w[0] << 16) * (f * g0[0]), __uint_as_float(w[0] & 0xffff0000u) * (f * g0[1]));
  o[1] = cvtpk(__uint_as_float(w[1] << 16) * (f * g0[2]), __uint_as_float(w[1] & 0xffff0000u) * (f * g0[3]));
  o[2] = cvtpk(__uint_as_float(w[2] << 16) * (f * g1[0]), __uint_as_float(w[2] & 0xffff0000u) * (f * g1[1]));
  o[3] = cvtpk(__uint_as_float(w[3] << 16) * (f * g1[2]), __uint_as_float(w[3] & 0xffff0000u) * (f * g1[3]));
  return *reinterpret_cast<bf16x8*>(&o);
}
__device__ __forceinline__ void gm_unit2(const bf16_t* __restrict__ P, const float* __restrict__ SSV, const u32x4* __restrict__ WPA, const float* __restrict__ BSP,
                                         const float* __restrict__ GGM, bf16_t* __restrict__ OGM, int chunk, int gp, char* lds, float* rv) {
  int tid_ = threadIdx.x; asm volatile("" : "+v"(tid_));
  const int tid = tid_, wid = __builtin_amdgcn_readfirstlane(tid >> 6), lane = tid & 63, r32 = lane & 31, hi = lane >> 5;
  const int gsel = wid >> 2, w4 = wid & 3, g = 2 * gp + gsel, t = 32 * w4 + r32;
  const int sr = tid >> 4, sc = (tid & 15) * 8;
  const size_t t0 = (size_t)chunk * 128;
  char* ut = lds + 65536;
  const int vb0 = (int)(uintptr_t)lds + v_rd_base(lane);
  __syncthreads();
  { const int row = tid >> 2, part = tid & 3; const f32x4 v = *(const f32x4*)(SSV + (t0 + row) * 16 + part * 4); float s = (v[0] + v[1]) + (v[2] + v[3]);
    s += __shfl_xor(s, 1); s += __shfl_xor(s, 2); if (part == 0) rv[row] = __builtin_amdgcn_rsqf(s * (1.0f / 1024.0f) + EPS); }
  bf16x8 pa[2][4]; f32x4 ggv[2][2]; float bias;
  { bf16x8 vg[2][4], uu[8];
#pragma unroll
    for (int grp = 0; grp < 2; ++grp)
#pragma unroll
      for (int rr = 0; rr < 4; ++rr) vg[grp][rr] = *reinterpret_cast<const bf16x8*>(P + (t0 + rr * 32 + sr) * LDP + PC_VG + (2 * gp + grp) * 128 + sc);
#pragma unroll
    for (int i = 0; i < 8; ++i) { const int c = tid + 512 * i, row = c >> 5, part = c & 31; uu[i] = *reinterpret_cast<const bf16x8*>(P + (t0 + row) * LDP + PC_U + 2 * gp * 128 + part * 8); }
#pragma unroll
    for (int j = 0; j < 2; ++j)
#pragma unroll
      for (int ks = 0; ks < 4; ++ks) {
        if (64 * j + 16 * ks > 32 * w4 + 31) { pa[j][ks] = bf16x8{}; continue; }
        const u32x4 w = WPA[(size_t)((((g * 4 + w4) * 2 + j) * 4 + ks) * 64 + lane)]; pa[j][ks] = *reinterpret_cast<const bf16x8*>(&w); }
#pragma unroll
    for (int grp = 0; grp < 2; ++grp) { ggv[grp][0] = *(const f32x4*)(GGM + (2 * gp + grp) * 128 + sc); ggv[grp][1] = *(const f32x4*)(GGM + (2 * gp + grp) * 128 + sc + 4); }
    bias = BSP[g * 128 + t];
    __syncthreads();
#pragma unroll
    for (int grp = 0; grp < 2; ++grp)
#pragma unroll
      for (int rr = 0; rr < 4; ++rr) { const int s = rr * 32 + sr; *(bf16x8*)(lds + (grp * 2 + (s >> 6)) * SHM_V + v_st(s & 63, sc)) = scale8(vg[grp][rr], rv[s], ggv[grp][0], ggv[grp][1]); }
#pragma unroll
    for (int i = 0; i < 8; ++i) { const int c = tid + 512 * i, row = c >> 5, part = c & 31; *(bf16x8*)(ut + row * 512 + ((part ^ (row & 31)) << 4)) = uu[i]; } }
  __syncthreads();
  f32x16 o[4] = {};
  { const int vb = vb0 + (gsel * 2) * SHM_V;
    pv_one_t<0>(o[0], vb, pa[0][0], pa[0][1], pa[0][2], pa[0][3]); pv_one_t<1>(o[1], vb, pa[0][0], pa[0][1], pa[0][2], pa[0][3]);
    pv_one_t<2>(o[2], vb, pa[0][0], pa[0][1], pa[0][2], pa[0][3]); pv_one_t<3>(o[3], vb, pa[0][0], pa[0][1], pa[0][2], pa[0][3]); }
  if (w4 >= 2) { const int vb = vb0 + (gsel * 2 + 1) * SHM_V;
    pv_one_t<0>(o[0], vb, pa[1][0], pa[1][1], pa[1][2], pa[1][3]); pv_one_t<1>(o[1], vb, pa[1][0], pa[1][1], pa[1][2], pa[1][3]);
    pv_one_t<2>(o[2], vb, pa[1][0], pa[1][1], pa[1][2], pa[1][3]); pv_one_t<3>(o[3], vb, pa[1][0], pa[1][1], pa[1][2], pa[1][3]); }
  { char* urow = ut + t * 512 + 8 * hi;
#pragma unroll
    for (int d0 = 0; d0 < 4; ++d0)
#pragma unroll
      for (int q = 0; q < 4; ++q) { unsigned long long* p = (unsigned long long*)(urow + (((gsel * 16 + d0 * 4 + q) ^ r32) << 4));
        const unsigned long long uv = *p; const unsigned ua = (unsigned)uv, ub = (unsigned)(uv >> 32);
        const float a0 = __uint_as_float(ua << 16) * (o[d0][4 * q] + bias), a1 = __uint_as_float(ua & 0xffff0000u) * (o[d0][4 * q + 1] + bias);
        const float a2 = __uint_as_float(ub << 16) * (o[d0][4 * q + 2] + bias), a3 = __uint_as_float(ub & 0xffff0000u) * (o[d0][4 * q + 3] + bias);
        *p = (unsigned long long)cvtpk(a0, a1) | ((unsigned long long)cvtpk(a2, a3) << 32); } }
  __syncthreads();
#pragma unroll
  for (int i = 0; i < 8; ++i) { const int c = tid + 512 * i, row = c >> 5, part = c & 31;
    *(bf16x8*)(OGM + (t0 + row) * 1024 + 2 * gp * 128 + part * 8) = *(const bf16x8*)(ut + row * 512 + ((part ^ (row & 31)) << 4)); }
}

constexpr float XSCALE = 0.088388347648318440f, THR = 8.f;
__device__ __forceinline__ void partialSM(f32x16& p0, f32x16& p1, float& m_reg, float& mn, float& alpha) {
  constexpr float Cc = XSCALE * 1.4426950408889634f;
  float pmax = p0[0];
#pragma unroll
  for (int r = 1; r < 16; ++r) pmax = fmaxf(pmax, p0[r]);
#pragma unroll
  for (int r = 0; r < 16; ++r) pmax = fmaxf(pmax, p1[r]);
  { auto rr = __builtin_amdgcn_permlane32_swap(__float_as_uint(pmax), __float_as_uint(pmax), false, false);
    pmax = fmaxf(__uint_as_float(rr[0]), __uint_as_float(rr[1])); }
  if (__builtin_expect(__all(pmax - m_reg <= THR / XSCALE), 1)) { mn = m_reg; alpha = 1.f; }
  else { mn = fmaxf(m_reg, pmax); alpha = __builtin_amdgcn_exp2f((m_reg - mn) * Cc); m_reg = mn; }
  float mnC = -mn * Cc;
#pragma unroll
  for (int r = 0; r < 16; ++r) p0[r] = fmaf(p0[r], Cc, mnC);
#pragma unroll
  for (int r = 0; r < 16; ++r) p1[r] = fmaf(p1[r], Cc, mnC);
#pragma unroll
  for (int r = 0; r < 16; ++r) p0[r] = __builtin_amdgcn_exp2f(p0[r]);
}
__device__ __forceinline__ void finishSM(f32x16& p0, f32x16& p1, float alpha, float& l_reg, bf16x8& pa0, bf16x8& pa1, bf16x8& pa2, bf16x8& pa3) {
#pragma unroll
  for (int r = 0; r < 16; ++r) p1[r] = __builtin_amdgcn_exp2f(p1[r]);
  float ps = 0;
#pragma unroll
  for (int r = 0; r < 16; ++r) ps += p0[r];
#pragma unroll
  for (int r = 0; r < 16; ++r) ps += p1[r];
  { auto rr = __builtin_amdgcn_permlane32_swap(__float_as_uint(ps), __float_as_uint(ps), false, false);
    ps = __uint_as_float(rr[0]) + __uint_as_float(rr[1]); }
  l_reg = l_reg * alpha + ps;
  PK4(p0, 0, pa0); PK4(p0, 8, pa1); PK4(p1, 0, pa2); PK4(p1, 8, pa3);
}
template <int LDQ, int LDK, int LDO>
__device__ __forceinline__ void xattn_unit(const bf16_t* __restrict__ Qb, const bf16_t* __restrict__ Kh, const bf16_t* __restrict__ Vh, bf16_t* __restrict__ Ob, int seq, char* lds, lds_u16* stg) {
  int tid_ = threadIdx.x; asm volatile("" : "+v"(tid_));
  const int tid = tid_, wid = __builtin_amdgcn_readfirstlane(tid >> 6), lane = tid & 63, r32 = lane & 31, hi = lane >> 5;
  bf16_t* V_lds = (bf16_t*)lds; bf16_t* K_lds = (bf16_t*)(lds + SHM_V);
  float* ws = (float*)(lds + SHM_V + SHM_K) + wid * 64; float* li_l = ws; float* al_l = ws + 32;
  float m_reg = -1e30f, l_reg = 0; f32x16 o[4] = {}; bf16x8 qr[8];
  const bf16_t* Qw = Qb + (size_t)(wid * 32 + r32) * LDQ + hi * 8;
#pragma unroll
  for (int d0 = 0; d0 < 8; ++d0) qr[d0] = *reinterpret_cast<const bf16x8*>(Qw + d0 * 16);
  const int sr = tid >> 4, sc = (tid & 15) * 8, vst0 = v_st(sr, sc), vst1 = v_st(32 + sr, sc);
  const int vb0 = (int)(uintptr_t)V_lds + v_rd_base(lane);
  bf16x8 vs0, vs1, ks0, ks1;
#define SLOAD(k0) do { vs0 = *reinterpret_cast<const bf16x8*>(&Vh[(size_t)((k0) + sr) * LDK + sc]); vs1 = *reinterpret_cast<const bf16x8*>(&Vh[(size_t)((k0) + 32 + sr) * LDK + sc]); \
    ks0 = *reinterpret_cast<const bf16x8*>(&Kh[(size_t)((k0) + sr) * LDK + sc]); ks1 = *reinterpret_cast<const bf16x8*>(&Kh[(size_t)((k0) + 32 + sr) * LDK + sc]); } while (0)
#define SWRITE() do { *(bf16x8*)((char*)V_lds + vst0) = vs0; *(bf16x8*)((char*)V_lds + vst1) = vs1; \
    *(bf16x8*)((char*)K_lds + KSWZ(sr, sc * 2)) = ks0; *(bf16x8*)((char*)K_lds + KSWZ(32 + sr, sc * 2)) = ks1; } while (0)
  const int NT = seq / 64;
  SLOAD(0);
  for (int j = 0; j < NT; ++j) {
    asm volatile("s_waitcnt vmcnt(0)" ::: "memory");
    __syncthreads();
    SWRITE();
    if (j + 1 < NT) SLOAD((j + 1) * 64);
    __syncthreads();
    f32x16 p0, p1; float mn, alpha; bf16x8 pa0, pa1, pa2, pa3;
    qkt(p0, p1, K_lds, qr, r32, hi);
    partialSM(p0, p1, m_reg, mn, alpha);
    if (__any(alpha < 1.f)) { if (hi == 0) al_l[r32] = alpha; asm volatile("s_waitcnt lgkmcnt(0)" ::: "memory");
#pragma unroll
      for (int d = 0; d < 4; ++d)
#pragma unroll
        for (int r = 0; r < 16; ++r) o[d][r] *= al_l[crow(r, hi)]; }
    finishSM(p0, p1, alpha, l_reg, pa0, pa1, pa2, pa3);
    pv_d0(o, vb0, pa0, pa1, pa2, pa3);
  }
  if (hi == 0) li_l[r32] = l_reg; asm volatile("s_waitcnt lgkmcnt(0)" ::: "memory");
  float rli[16];
#pragma unroll
  for (int r = 0; r < 16; ++r) rli[r] = __builtin_amdgcn_rcpf(li_l[crow(r, hi)]);
  store_o_bf16(o, rli, Ob + (size_t)(wid * 32) * LDO, LDO, lane, stg + wid * 1024);
#undef SLOAD
#undef SWRITE
}
#undef PK4
#undef KSWZ
#undef SBAR
}

constexpr int NWAVES = 8;
#ifndef PHASE_MASK
#define PHASE_MASK 0xFFFF
#endif
#ifndef REP_MASK
#define REP_MASK 0x0
#endif
#if REP_MASK == 0
#define PH(k) if constexpr ((PHASE_MASK >> (k)) & 1)
#else
#define PH(k) for (int rep_ = 0; rep_ < ((((PHASE_MASK) >> (k)) & 1) ? ((((REP_MASK) >> (k)) & 1) ? 2 : 1) : 0); ++rep_)
#endif
constexpr size_t MiB = 1u << 20;
constexpr size_t WS_CTL = 0, CTL_ZERO_BYTES = 128 * 1024;
constexpr size_t WS_SSV = 1 * MiB;
constexpr size_t WS_SS1 = 3 * MiB;
constexpr size_t WS_WPA = 7 * MiB + 768 * 1024;
constexpr size_t WS_XINV = 7 * MiB + 512 * 1024;
constexpr size_t WS_MG = 224 * MiB;
constexpr size_t WS_WRH = 7 * MiB, WS_WRL = 7 * MiB + 256 * 1024;
constexpr size_t WS_TOKL = 8 * MiB, WS_SLOTL = 12 * MiB, WS_WL = 16 * MiB, WS_RSL = 20 * MiB;
constexpr size_t WS_MEMN = 24 * MiB;
constexpr size_t WS_MKV = 26 * MiB;
constexpr size_t WS_WIN = 32 * MiB, WS_WSB = 68 * MiB, WS_WGM = 72 * MiB, WS_WOUT = 76 * MiB, WS_WXQ = 84 * MiB, WS_WXKV = 86 * MiB, WS_WXO = 90 * MiB;
constexpr size_t WS_W1 = 96 * MiB;
constexpr size_t WS_W2 = 352 * MiB;
constexpr size_t WS_PROJ = 480 * MiB;
constexpr size_t WS_X1F = 480 * MiB;
constexpr size_t WS_X1B = 736 * MiB;
constexpr size_t WS_QX = 864 * MiB;
constexpr size_t WS_OX = 896 * MiB;
constexpr size_t WS_X2B = 928 * MiB;
constexpr size_t WS_X28 = 552 * MiB;
constexpr size_t WS_H = 480 * MiB;
constexpr size_t WS_Y = 624 * MiB;
constexpr size_t WS_END = 1056 * MiB;
constexpr size_t DO_XB = 0, DO_OSB = 128 * MiB, DO_OGM = 192 * MiB, DO_MG = 0;
constexpr int CW_BAR = 4096;
constexpr int CW_CNT = 16384;
constexpr int RING_BYTES = 131072, LDSCTL_OFF = RING_BYTES, MISC_OFF = LDSCTL_OFF + 320, TB_OFF = LDSCTL_OFF + 512, HIST_OFF = LDSCTL_OFF + 768, BASE_OFF = LDSCTL_OFF + 1024, SBFLAG_OFF = LDSCTL_OFF + 1280, STG_OFF = LDSCTL_OFF + 2048;
constexpr int LDS_BYTES = 151552;

#define GAS __attribute__((address_space(1)))
#define LAS __attribute__((address_space(3)))
typedef unsigned short bf16;
typedef unsigned v4u __attribute__((ext_vector_type(4)));
typedef float f32x4 __attribute__((ext_vector_type(4)));
typedef short bf16x8 __attribute__((ext_vector_type(8)));
typedef GAS unsigned gu32;
#define RLX_AGENT __ATOMIC_RELAXED, __HIP_MEMORY_SCOPE_AGENT
#define LDS_WAIT() asm volatile("s_waitcnt lgkmcnt(0)" ::: "memory")
#define VM_WAIT() asm volatile("s_waitcnt vmcnt(0)" ::: "memory")
__device__ __forceinline__ unsigned f2bf(float f) { unsigned u = __builtin_bit_cast(unsigned, f); return (u + 0x7fffu + ((u >> 16) & 1u)) >> 16; }
__device__ __forceinline__ unsigned pk2(float lo, float hi) { return f2bf(lo) | (f2bf(hi) << 16); }

#define XB_TMO      128
#define XB_XCNT(j)  (256  + 64 * (j))
#define XB_XSUB(j)  (1280 + 64 * (j))
#define XB_XGEN(j)  (2304 + 64 * (j))
#define XB_TOP      3328
#define XB_TOPGEN   3392
#define XCD_BAR_WORDS 3456
#define XB_SPIN_CAP (1u << 18)
__device__ __forceinline__ unsigned xb_ld(unsigned* p)              { return __hip_atomic_load(p, __ATOMIC_RELAXED, __HIP_MEMORY_SCOPE_AGENT); }
__device__ __forceinline__ unsigned xb_add(unsigned* p, unsigned v) { return __hip_atomic_fetch_add(p, v, __ATOMIC_RELAXED, __HIP_MEMORY_SCOPE_AGENT); }
__device__ __forceinline__ unsigned xb_xcc_id() { return (unsigned)__builtin_amdgcn_s_getreg((3 << 11) | 20) & 0xFu; }
#define XB_SPIN(cond, bar) do { unsigned _sp = 0; while (cond) { __builtin_amdgcn_s_sleep(1); \
    if ((++_sp & 255u) == 0u) { if (xb_ld(&(bar)[XB_TMO])) break; if (_sp > XB_SPIN_CAP) { atomicAdd(&(bar)[XB_TMO], 1u); break; } } } } while (0)
struct XcdBarrier { unsigned* bar; unsigned x; volatile LAS unsigned* st; };
__device__ __forceinline__ XcdBarrier xcd_barrier_post(unsigned* bar, volatile LAS unsigned* st) {
    XcdBarrier b; b.bar = bar; b.x = xb_xcc_id(); b.st = st;
    if (threadIdx.x == 0) (void)xb_add(&bar[XB_XCNT(b.x)], 1u);
    return b;
}
__device__ __forceinline__ void xcd_barrier_complete(unsigned* bar, unsigned x, unsigned& nloc, unsigned& nx) {
    const unsigned G = gridDim.x * gridDim.y * gridDim.z;
    unsigned sum, cnt, mine, sp = 0u;
    for (;;) {
        sum = 0u; cnt = 0u; mine = 0u;
#pragma unroll
        for (unsigned j = 0; j < 16; ++j) { const unsigned c = xb_ld(&bar[XB_XCNT(j)]); sum += c; cnt += (c > 0u) ? 1u : 0u; mine = (j == x) ? c : mine; }
        if (sum == G) break;
        __builtin_amdgcn_s_sleep(1);
        if ((++sp & 255u) == 0u) { if (xb_ld(&bar[XB_TMO])) break; if (sp > XB_SPIN_CAP) { atomicAdd(&bar[XB_TMO], 1u); break; } }
    }
    nloc = mine > 0u ? mine : 1u; nx = cnt > 0u ? cnt : 1u;
}
__device__ __forceinline__ void xcd_barrier(const XcdBarrier& b) {
    asm volatile("s_waitcnt vmcnt(0)" ::: "memory");
    __syncthreads();
    if (threadIdx.x == 0) {
        unsigned* bar = b.bar;
        __builtin_amdgcn_s_waitcnt(0);
        unsigned nloc = b.st[0], nx = b.st[1];
        if (nloc == 0u) { xcd_barrier_complete(bar, b.x, nloc, nx); b.st[0] = nloc; b.st[1] = nx; }
        const unsigned old = xb_add(&bar[XB_XSUB(b.x)], 1u);
        const unsigned gen = old / nloc;
        if (old + 1u == (gen + 1u) * nloc) {
            __builtin_amdgcn_fence(__ATOMIC_RELEASE, "agent");
            asm volatile("s_waitcnt vmcnt(0)" ::: "memory");
            const unsigned og = xb_add(&bar[XB_TOP], 1u);
            const unsigned tg = og / nx;
            if (og + 1u == (tg + 1u) * nx) xb_add(&bar[XB_TOPGEN], 1u);
            else XB_SPIN(xb_ld(&bar[XB_TOPGEN]) == tg, bar);
            __builtin_amdgcn_fence(__ATOMIC_ACQUIRE, "agent");
            xb_add(&bar[XB_XGEN(b.x)], 1u);
            asm volatile("s_waitcnt vmcnt(0)" ::: "memory");
        } else {
            XB_SPIN(xb_ld(&bar[XB_XGEN(b.x)]) == gen, bar);
            __builtin_amdgcn_fence(__ATOMIC_ACQUIRE, "agent");
            asm volatile("s_waitcnt vmcnt(0)" ::: "memory");
        }
    }
    __syncthreads();
}

__device__ __forceinline__ float wave_sum(float v) {
#pragma unroll
    for (int o = 1; o < 64; o <<= 1) v += __shfl_xor(v, o);
    return v;
}
__device__ __forceinline__ void transpose_item(const float* W, int K, int N, bf16* WT, int k0, int n0, int drow0, const float* gk, LAS float* scr, int lane, float cs = 1.0f) {
    { f32x4 ld[8];
#pragma unroll
      for (int i = 0; i < 8; ++i) ld[i] = *(const GAS f32x4*)(W + (size_t)(k0 + 8 * i + (lane >> 3)) * N + n0 + 4 * (lane & 7));
#pragma unroll
      for (int i = 0; i < 8; ++i) { LAS float* p = scr + (8 * i + (lane >> 3)) * 33 + 4 * (lane & 7); p[0] = ld[i].x; p[1] = ld[i].y; p[2] = ld[i].z; p[3] = ld[i].w; } }
    LDS_WAIT(); asm volatile("" ::: "memory");
    const int c = lane & 7;
    float gs[8];
#pragma unroll
    for (int q = 0; q < 8; ++q) gs[q] = (gk ? gk[k0 + 8 * c + q] : 1.0f) * cs;
#pragma unroll
    for (int j = 0; j < 4; ++j) { const int n = (lane >> 3) + 8 * j; const LAS float* s = scr + (8 * c) * 33 + n;
        v4u o; o.x = pk2(s[0 * 33] * gs[0], s[1 * 33] * gs[1]); o.y = pk2(s[2 * 33] * gs[2], s[3 * 33] * gs[3]); o.z = pk2(s[4 * 33] * gs[4], s[5 * 33] * gs[5]); o.w = pk2(s[6 * 33] * gs[6], s[7 * 33] * gs[7]);
        *(GAS v4u*)(WT + (size_t)(drow0 + n) * K + k0 + 8 * c) = o; }
    LDS_WAIT(); asm volatile("" ::: "memory");
}
__device__ __forceinline__ void transpose_item_bf8(const float* W, int K, int N, unsigned char* WT, int k0, int n0, int drow0, const float* gk, LAS float* scr, int lane) {
    { f32x4 ld[8];
#pragma unroll
      for (int i = 0; i < 8; ++i) ld[i] = *(const GAS f32x4*)(W + (size_t)(k0 + 8 * i + (lane >> 3)) * N + n0 + 4 * (lane & 7));
#pragma unroll
      for (int i = 0; i < 8; ++i) { LAS float* p = scr + (8 * i + (lane >> 3)) * 33 + 4 * (lane & 7); p[0] = ld[i].x; p[1] = ld[i].y; p[2] = ld[i].z; p[3] = ld[i].w; } }
    LDS_WAIT(); asm volatile("" ::: "memory");
    const int c = lane & 7;
    float gs[8];
#pragma unroll
    for (int q = 0; q < 8; ++q) gs[q] = gk ? gk[k0 + 8 * c + q] : 1.0f;
#pragma unroll
    for (int j = 0; j < 4; ++j) { const int n = (lane >> 3) + 8 * j; const LAS float* s = scr + (8 * c) * 33 + n;
        int lo = __builtin_amdgcn_cvt_pk_bf8_f32(s[0 * 33] * gs[0], s[1 * 33] * gs[1], 0, false); lo = __builtin_amdgcn_cvt_pk_bf8_f32(s[2 * 33] * gs[2], s[3 * 33] * gs[3], lo, true);
        int hi = __builtin_amdgcn_cvt_pk_bf8_f32(s[4 * 33] * gs[4], s[5 * 33] * gs[5], 0, false); hi = __builtin_amdgcn_cvt_pk_bf8_f32(s[6 * 33] * gs[6], s[7 * 33] * gs[7], hi, true);
        *(GAS unsigned long long*)(WT + (size_t)(drow0 + n) * K + k0 + 8 * c) = (unsigned long long)(unsigned)lo | ((unsigned long long)(unsigned)hi << 32); }
    LDS_WAIT(); asm volatile("" ::: "memory");
}
__device__ __forceinline__ void transpose_item_fp8(const float* W, int K, int N, unsigned char* WT, int k0, int n0, int drow0, const float* gk, LAS float* scr, int lane, float cs) {
    { f32x4 ld[8];
#pragma unroll
      for (int i = 0; i < 8; ++i) ld[i] = *(const GAS f32x4*)(W + (size_t)(k0 + 8 * i + (lane >> 3)) * N + n0 + 4 * (lane & 7));
#pragma unroll
      for (int i = 0; i < 8; ++i) { LAS float* p = scr + (8 * i + (lane >> 3)) * 33 + 4 * (lane & 7); p[0] = ld[i].x; p[1] = ld[i].y; p[2] = ld[i].z; p[3] = ld[i].w; } }
    LDS_WAIT(); asm volatile("" ::: "memory");
    const int c = lane & 7;
    float gs[8];
#pragma unroll
    for (int q = 0; q < 8; ++q) gs[q] = (gk ? gk[k0 + 8 * c + q] : 1.0f) * cs;
#pragma unroll
    for (int j = 0; j < 4; ++j) { const int n = (lane >> 3) + 8 * j; const LAS float* s = scr + (8 * c) * 33 + n;
        int lo = __builtin_amdgcn_cvt_pk_fp8_f32(s[0 * 33] * gs[0], s[1 * 33] * gs[1], 0, false); lo = __builtin_amdgcn_cvt_pk_fp8_f32(s[2 * 33] * gs[2], s[3 * 33] * gs[3], lo, true);
        int hi = __builtin_amdgcn_cvt_pk_fp8_f32(s[4 * 33] * gs[4], s[5 * 33] * gs[5], 0, false); hi = __builtin_amdgcn_cvt_pk_fp8_f32(s[6 * 33] * gs[6], s[7 * 33] * gs[7], hi, true);
        *(GAS unsigned long long*)(WT + (size_t)(drow0 + n) * K + k0 + 8 * c) = (unsigned long long)(unsigned)lo | ((unsigned long long)(unsigned)hi << 32); }
    LDS_WAIT(); asm volatile("" ::: "memory");
}
struct TItem { const float* src; int N, k0, n0; unsigned char* dst; int kb, drow0; const float* gk; float cs; int fp8; };
__device__ __forceinline__ void titem_load(const TItem& t, f32x4 (&ld)[8], float (&gs)[8], int lane) {
#pragma unroll
    for (int i = 0; i < 8; ++i) ld[i] = *(const GAS f32x4*)(t.src + (size_t)(t.k0 + 8 * i + (lane >> 3)) * t.N + t.n0 + 4 * (lane & 7));
    const int c = lane & 7;
#pragma unroll
    for (int q = 0; q < 8; ++q) gs[q] = t.gk ? t.gk[t.k0 + 8 * c + q] * t.cs : t.cs;
}
__device__ __forceinline__ void titem_finish(const TItem& t, const f32x4 (&ld)[8], const float (&gs)[8], LAS float* scr, int lane) {
#pragma unroll
    for (int i = 0; i < 8; ++i) { LAS float* p = scr + (8 * i + (lane >> 3)) * 33 + 4 * (lane & 7); p[0] = ld[i].x; p[1] = ld[i].y; p[2] = ld[i].z; p[3] = ld[i].w; }
    LDS_WAIT(); asm volatile("" ::: "memory");
    const int c = lane & 7;
    if (t.fp8) {
#pragma unroll
        for (int j = 0; j < 4; ++j) { const int n = (lane >> 3) + 8 * j; const LAS float* s = scr + (8 * c) * 33 + n;
            int lo = __builtin_amdgcn_cvt_pk_fp8_f32(s[0 * 33] * gs[0], s[1 * 33] * gs[1], 0, false); lo = __builtin_amdgcn_cvt_pk_fp8_f32(s[2 * 33] * gs[2], s[3 * 33] * gs[3], lo, true);
            int hi = __builtin_amdgcn_cvt_pk_fp8_f32(s[4 * 33] * gs[4], s[5 * 33] * gs[5], 0, false); hi = __builtin_amdgcn_cvt_pk_fp8_f32(s[6 * 33] * gs[6], s[7 * 33] * gs[7], hi, true);
            *(GAS unsigned long long*)(t.dst + (size_t)(t.drow0 + n) * t.kb + t.k0 + 8 * c) = (unsigned long long)(unsigned)lo | ((unsigned long long)(unsigned)hi << 32); }
    } else {
#pragma unroll
        for (int j = 0; j < 4; ++j) { const int n = (lane >> 3) + 8 * j; const LAS float* s = scr + (8 * c) * 33 + n;
            v4u o; o.x = pk2(s[0 * 33] * gs[0], s[1 * 33] * gs[1]); o.y = pk2(s[2 * 33] * gs[2], s[3 * 33] * gs[3]); o.z = pk2(s[4 * 33] * gs[4], s[5 * 33] * gs[5]); o.w = pk2(s[6 * 33] * gs[6], s[7 * 33] * gs[7]);
            *(GAS v4u*)(t.dst + (size_t)(t.drow0 + n) * t.kb + (size_t)(t.k0 + 8 * c) * 2) = o; }
    }
    LDS_WAIT(); asm volatile("" ::: "memory");
}
__device__ __forceinline__ void rms_row_to_bf16(const float* xrow, bf16* orow, int lane, float* inv_out = nullptr, unsigned char* o8row = nullptr) {
    const GAS f32x4* xr = (const GAS f32x4*)xrow + lane;
    f32x4 v[8]; float s = 0.f;
#pragma unroll
    for (int j = 0; j < 8; ++j) { v[j] = xr[64 * j]; s += (v[j].x * v[j].x + v[j].y * v[j].y) + (v[j].z * v[j].z + v[j].w * v[j].w); }
    const float ms = wave_sum(s) * (1.f / DM) + EPS; const float rstd = __builtin_amdgcn_rsqf(ms);
    if (inv_out && lane == 0) *inv_out = __builtin_sqrtf(ms);
    GAS unsigned long long* o8 = (GAS unsigned long long*)orow + lane;
#pragma unroll
    for (int j = 0; j < 8; ++j) o8[64 * j] = (unsigned long long)pk2(v[j].x * rstd, v[j].y * rstd) | ((unsigned long long)pk2(v[j].z * rstd, v[j].w * rstd) << 32);
    if (o8row) {
#pragma unroll
        for (int j = 0; j < 8; ++j) ((GAS unsigned*)o8row)[lane + 64 * j] = pg8::pk_fp8x4(v[j].x * rstd, v[j].y * rstd, v[j].z * rstd, v[j].w * rstd); }
}

struct Args { const float* in[24]; float* out; unsigned char* ws; };

__global__ void __launch_bounds__(NWAVES * 64, 2) fwd_kernel(Args args) {
    extern __shared__ __attribute__((aligned(16))) unsigned char lds[];
    LAS unsigned char* L = (LAS unsigned char*)lds;
    volatile LAS unsigned* MISC = (volatile LAS unsigned*)(L + MISC_OFF);
    const int tid = threadIdx.x, lane = tid & 63, wave = __builtin_amdgcn_readfirstlane(tid >> 6);
    const int G = gridDim.x; const int bx = blockIdx.x; const int vcu = (G % 8 == 0) ? (bx % 8) * (G / 8) + bx / 8 : bx;
    gu32* ctl = (gu32*)(args.ws + WS_CTL);
#define INP(k) (args.in[k])
#define p_x (INP(0))
#define p_mem (INP(1))
#define p_g_mix (INP(2))
#define p_w_in (INP(3))
#define p_g_gm (INP(4))
#define p_w_spatial (INP(5))
#define p_b_spatial (INP(6))
#define p_w_bsb (INP(7))
#define p_w_bgm (INP(8))
#define p_w_out (INP(9))
#define p_g_cross (INP(10))
#define p_g_mem (INP(11))
#define p_w_xq (INP(12))
#define p_w_xkv (INP(13))
#define p_w_xo (INP(14))
#define p_g_ffn (INP(15))
#define p_w_rg (INP(16))
#define p_b_rg (INP(17))
#define p_w_re (INP(18))
#define p_b_re (INP(19))
#define p_w_eg (INP(20))
#define p_w_eu (INP(21))
#define p_w_ed (INP(22))
#define p_g_final (INP(23))
#define WSPTR(ty, off) ((ty*)(args.ws + (off)))
#define DOPTR(ty, off) ((ty*)((unsigned char*)args.out + (off)))
#define SSV WSPTR(float, WS_SSV)
#define SS1 WSPTR(float, WS_SS1)
#define WRH WSPTR(bf16, WS_WRH)
#define WRL WSPTR(bf16, WS_WRL)
#define TOKL WSPTR(int, WS_TOKL)
#define SLOTL WSPTR(int, WS_SLOTL)
#define WL WSPTR(float, WS_WL)
#define RSL WSPTR(float, WS_RSL)
#define MEMN WSPTR(bf16, WS_MEMN)
#define MKV WSPTR(bf16, WS_MKV)
#define WIN WSPTR(bf16, WS_WIN)
#define WSB WSPTR(bf16, WS_WSB)
#define WGM WSPTR(bf16, WS_WGM)
#define WOUT WSPTR(bf16, WS_WOUT)
#define WXQ WSPTR(bf16, WS_WXQ)
#define WXKV WSPTR(bf16, WS_WXKV)
#define WXO WSPTR(bf16, WS_WXO)
#define W1 WSPTR(bf16, WS_W1)
#define W2 WSPTR(bf16, WS_W2)
#define PROJ WSPTR(bf16, WS_PROJ)
#define X1F WSPTR(float, WS_X1F)
#define X1B WSPTR(bf16, WS_X1B)
#define QX WSPTR(bf16, WS_QX)
#define OX WSPTR(bf16, WS_OX)
#define X2B WSPTR(bf16, WS_X2B)
#define X28 WSPTR(bf16, WS_X28)
#define HB WSPTR(bf16, WS_H)
#define YB WSPTR(bf16, WS_Y)
#define XB DOPTR(bf16, DO_XB)
#define XB8 DOPTR(unsigned char, DO_OSB)
#define WG8 (WSPTR(unsigned char, WS_WIN) + (size_t)PC_GS * DM * 2)
#define OSB DOPTR(bf16, DO_OSB)
#define OGM DOPTR(bf16, DO_OGM)
#define MG WSPTR(bf16, WS_MG)
#define XINV WSPTR(float, WS_XINV)
#define X2F (args.out)

    for (int u = tid; u < (LDS_BYTES - LDSCTL_OFF) / 4; u += NWAVES * 64) ((LAS unsigned*)(L + LDSCTL_OFF))[u] = 0u;
    __syncthreads();
    XcdBarrier bar = xcd_barrier_post((unsigned*)(ctl + CW_BAR), MISC + 8);
    const int gw = vcu * NWAVES + wave, NGW = G * NWAVES;

    PH(0) {
    {
        LAS float* scr = (LAS float*)(L + wave * 16384);
        constexpr int I_IN = 32 * 288, I_SB = 16 * 64, I_GM = 16 * 64, I_OUT = 32 * 64, I_XQ = 32 * 16, I_XKV = 32 * 32, I_XO = 8 * 64, I_EG = 32 * 32, I_ED = 16 * 64;
        constexpr int NSMALL = I_IN + I_SB + I_GM + I_OUT + I_XQ + I_XKV + I_XO;
        constexpr int NITEMS = NSMALL + NEXP * (2 * I_EG + I_ED);
        auto decode = [&](int r, TItem& t) {
            t.gk = nullptr; t.cs = 1.0f; t.fp8 = 0;
            if (r < I_IN) { const int nb = 288, n0 = 32 * (r % nb); t.src = p_w_in; t.N = 9216; t.k0 = 64 * (r / nb); t.n0 = n0; t.gk = p_g_mix;
                if (n0 < PC_GS) { t.dst = (unsigned char*)WIN; t.kb = 2048 * 2; t.drow0 = n0; }
                else { t.dst = WG8; t.kb = 2048; t.drow0 = n0 - PC_GS; t.fp8 = 1; t.cs = -1.4426950408889634f * 16.0f; }
                return; } r -= I_IN;
            if (r < I_SB) { const int nb = 64; t.src = p_w_bsb; t.N = 2048; t.k0 = 64 * (r / nb); t.n0 = 32 * (r % nb); t.dst = (unsigned char*)WSB; t.kb = 1024 * 2; t.drow0 = t.n0; return; } r -= I_SB;
            if (r < I_GM) { const int nb = 64; t.src = p_w_bgm; t.N = 2048; t.k0 = 64 * (r / nb); t.n0 = 32 * (r % nb); t.dst = (unsigned char*)WGM; t.kb = 1024 * 2; t.drow0 = t.n0; return; } r -= I_GM;
            if (r < I_OUT) { const int nb = 64; t.src = p_w_out; t.N = 2048; t.k0 = 64 * (r / nb); t.n0 = 32 * (r % nb); t.dst = (unsigned char*)WOUT; t.kb = 2048 * 2; t.drow0 = t.n0; return; } r -= I_OUT;
            if (r < I_XQ) { const int nb = 16; t.src = p_w_xq; t.N = 512; t.k0 = 64 * (r / nb); t.n0 = 32 * (r % nb); t.dst = (unsigned char*)WXQ; t.kb = 2048 * 2; t.drow0 = t.n0; t.gk = p_g_cross; return; } r -= I_XQ;
            if (r < I_XKV) { const int nb = 32; t.src = p_w_xkv; t.N = 1024; t.k0 = 64 * (r / nb); t.n0 = 32 * (r % nb); t.dst = (unsigned char*)WXKV; t.kb = 2048 * 2; t.drow0 = t.n0; t.gk = p_g_mem; return; } r -= I_XKV;
            if (r < I_XO) { const int nb = 64; t.src = p_w_xo; t.N = 2048; t.k0 = 64 * (r / nb); t.n0 = 32 * (r % nb); t.dst = (unsigned char*)WXO; t.kb = 512 * 2; t.drow0 = t.n0; return; } r -= I_XO;
            const int e = r / (2 * I_EG + I_ED); r -= e * (2 * I_EG + I_ED); t.fp8 = 1; t.cs = 64.0f;
            if (r < 2 * I_EG) { const int up = r >= I_EG ? 1 : 0; r -= up * I_EG; const int nb = 32, n0 = 32 * (r % nb);
                t.src = (up ? p_w_eu : p_w_eg) + (size_t)e * 2048 * 1024; t.N = 1024; t.k0 = 64 * (r / nb); t.n0 = n0; t.dst = (unsigned char*)W1 + (size_t)e * 2048 * 2048; t.kb = 2048;
                t.drow0 = (n0 >> 7) * 256 + up * 128 + (n0 & 127); t.gk = p_g_ffn; return; }
            r -= 2 * I_EG;
            { const int nb = 64; t.src = p_w_ed + (size_t)e * 1024 * 2048; t.N = 2048; t.k0 = 64 * (r / nb); t.n0 = 32 * (r % nb); t.dst = (unsigned char*)W2 + (size_t)e * 2048 * 1024; t.kb = 1024; t.drow0 = t.n0; }
        };
        {
            TItem tc, tn; f32x4 lc[8], ln[8]; float gc[8], gn[8];
            int it = gw; bool hv = it < NITEMS;
            if (hv) { decode(it, tc); titem_load(tc, lc, gc, lane); }
            while (hv) {
                const int itn = it + NGW; const bool hn = itn < NITEMS;
                if (hn) { decode(itn, tn); titem_load(tn, ln, gn, lane); }
                titem_finish(tc, lc, gc, scr, lane);
                tc = tn;
#pragma unroll
                for (int i = 0; i < 8; ++i) { lc[i] = ln[i]; gc[i] = gn[i]; }
                it = itn; hv = hn;
            }
        }
        for (int m = gw; m < T; m += NGW) rms_row_to_bf16(p_x + (size_t)m * DM, XB + (size_t)m * DM, lane, XINV + m, XB8 + (size_t)m * DM);
        for (int m = gw; m < BATCH * NMEM; m += NGW) rms_row_to_bf16(p_mem + (size_t)m * DM, MEMN + (size_t)m * DM, lane);
        for (int i = bx * 512 + tid; i < NEXP * CAP; i += G * 512) { TOKL[i] = 0; SLOTL[i] = -1; }
        for (int i = bx * 512 + tid; i < 48 * 2048; i += G * 512) { const int e = i >> 11, k = i & 2047;
            float w = 0.f; if (e < 32) w = p_w_re[(size_t)k * 32 + e] * p_g_ffn[k]; else if (e < 36) w = p_w_rg[(size_t)k * 4 + (e - 32)] * p_g_ffn[k];
            const unsigned hb = f2bf(w); const float hf = __uint_as_float(hb << 16); WRH[i] = (bf16)hb; WRL[i] = (bf16)f2bf(w - hf); }
        for (int i = bx * 512 + tid; i < 8 * 4 * 2 * 4 * 64; i += G * 512) { const int ln = i & 63, ks = (i >> 6) & 3, j = (i >> 8) & 1, w4 = (i >> 9) & 3, g = i >> 11;
            const int t = 32 * w4 + (ln & 31), s0 = 64 * j + 16 * ks + 8 * (ln >> 5); const float* wr_ = p_w_spatial + ((size_t)g * 128 + t) * 128 + s0;
            float v[8];
#pragma unroll
            for (int k = 0; k < 8; ++k) v[k] = (s0 + k <= t) ? wr_[k] : 0.f;
            att::u32x4 o; o.x = att::cvtpk(v[0], v[1]); o.y = att::cvtpk(v[2], v[3]); o.z = att::cvtpk(v[4], v[5]); o.w = att::cvtpk(v[6], v[7]);
            WSPTR(att::u32x4, WS_WPA)[i] = o; }
    }
    }
    xcd_barrier(bar);

    PH(1) {
    {
        pg8::Gemm g{XB, WIN, T, PC_GS, DM}; pg8::StaticOrder S; S.init(T, PC_GS, G, bx);
        pg8::EpiIn E{PROJ, SSV};
        pg8::gemm_phase<pg8::EpiIn, pg8::StaticOrder, false>(L, g, S, E);
    }
    {
        pg8::Gemm g{(const pg8::bf16_t*)XB8, (const pg8::bf16_t*)WG8, T, LDP - PC_GS, DM / 2}; pg8::StaticOrder S; S.init(T, LDP - PC_GS, G, bx);
        pg8::EpiGateQ E{PROJ};
        pg8::gemm_phase<pg8::EpiGateQ, pg8::StaticOrder, false, true, 0, 0x7B7B7B7Bu>(L, g, S, E);
    }
    {
        typedef short bf16x8_ __attribute__((ext_vector_type(8))); typedef float f4_ __attribute__((ext_vector_type(4)));
        int tk_ = threadIdx.x; asm volatile("" : "+v"(tk_));
        const int ln_ = tk_ & 63, r_ = ln_ & 15, kq_ = ln_ >> 4;
        for (int t = vcu; t < 256; t += G) {
            const int row0 = (t >> 4) * 32 + (wave >> 2) * 16, col0 = (t & 15) * 64 + (wave & 3) * 16;
            const bf16* ap = MEMN + (size_t)(row0 + r_) * DM + 8 * kq_; const bf16* bp = WXKV + (size_t)(col0 + r_) * DM + 8 * kq_;
            f4_ acc[4] = {{0.f, 0.f, 0.f, 0.f}, {0.f, 0.f, 0.f, 0.f}, {0.f, 0.f, 0.f, 0.f}, {0.f, 0.f, 0.f, 0.f}};
#pragma unroll 2
            for (int ks = 0; ks < 64; ks += 4) {
                bf16x8_ a[4], b[4];
#pragma unroll
                for (int j = 0; j < 4; ++j) { a[j] = *(const bf16x8_*)(ap + 32 * (ks + j)); b[j] = *(const bf16x8_*)(bp + 32 * (ks + j)); }
#pragma unroll
                for (int j = 0; j < 4; ++j) acc[j] = __builtin_amdgcn_mfma_f32_16x16x32_bf16(b[j], a[j], acc[j], 0, 0, 0);
            }
            const f4_ s = (acc[0] + acc[1]) + (acc[2] + acc[3]);
            *(unsigned long long*)(MKV + (size_t)(row0 + r_) * 1024 + col0 + 4 * kq_) = (unsigned long long)pk2(s[0], s[1]) | ((unsigned long long)pk2(s[2], s[3]) << 32);
        }
    }
    }
    xcd_barrier(bar);

    PH(2) {
#pragma unroll 1
    for (int pass = 0; pass < 2; ++pass) {
        if ((pass ^ ((bx >> 3) & 1)) == 0) {
            for (int u = vcu; u < BATCH * 4 * 128; u += G) { const int qblk = u & 127, hp = (u >> 7) & 3, b = u >> 9;
                att::sb_unit(PROJ, OSB, b, hp, qblk, (char*)lds, L, (volatile LAS int*)(L + SBFLAG_OFF), (att::lds_u16*)(L + STG_OFF)); }
        } else {
            for (int u = vcu; u < 256 * 4; u += G) { const int gp = u & 3, chunk = u >> 2; att::gm_unit2(PROJ, SSV, WSPTR(att::u32x4, WS_WPA), p_b_spatial, p_g_gm, OGM, chunk, gp, (char*)lds, (float*)(lds + STG_OFF)); }
        }
        __syncthreads();
    }
    }
    xcd_barrier(bar);

    PH(3) {
    {
        pg8::Gemm g{OSB, WSB, T, DM, 1024}; pg8::PairOrder S; S.S.init(T, DM, G, bx); S.A1 = OGM; S.B1 = WGM;
        pg8::EpiGate3 E{PROJ, MG};
        pg8::gemm_phase<pg8::EpiGate3, pg8::PairOrder, false>(L, g, S, E);
    }
    }
    xcd_barrier(bar);

    PH(4) {
    {
        pg8::Gemm g{MG, WOUT, T, DM, DM}; pg8::StaticOrder S; S.init(T, DM, G, bx);
        pg8::EpiRes E{XB, XINV, X1B, SS1};
        pg8::gemm_phase<pg8::EpiRes, pg8::StaticOrder, false>(L, g, S, E);
    }
    }
    xcd_barrier(bar);

    PH(5) {
    pg8::StaticOrder S5; S5.init(T, 512, G, bx);
    {
        pg8::Gemm g{X1B, WXQ, T, 512, DM};
        pg8::EpiRowScale E{SS1, QX, 512};
        pg8::gemm_phase<pg8::EpiRowScale, pg8::StaticOrder, false>(L, g, S5, E);
    }
    asm volatile("s_waitcnt vmcnt(0)" ::: "memory"); __syncthreads();
    { pg8::Unit u;
      for (int i = 0; S5.next(i, u); ++i) { const int b = u.pm >> 6, qb = u.pm & 63;
#pragma unroll 1
        for (int hh = 0; hh < 2; ++hh) { const int h = 2 * u.pn + hh;
            att::xattn_unit<512, 1024, 512>(QX + ((size_t)b * SEQ + qb * 256) * 512 + h * 128, MKV + (size_t)b * NMEM * 1024 + h * 128, MKV + (size_t)b * NMEM * 1024 + 512 + h * 128,
                                           OX + ((size_t)b * SEQ + qb * 256) * 512 + h * 128, NMEM, (char*)lds, (att::lds_u16*)(L + STG_OFF)); } } }
    }
    xcd_barrier(bar);

    PH(7) {
    {
        pg8::Gemm g{OX, WXO, T, DM, 512}; pg8::StaticOrder S; S.init(T, DM, G, bx);
        pg8::EpiResB E{X1B, X2B, (unsigned char*)X28};
        pg8::gemm_phase<pg8::EpiResB, pg8::StaticOrder, false>(L, g, S, E);
    }
    }
    xcd_barrier(bar);

    PH(8) {
    int tid8_ = threadIdx.x; asm volatile("" : "+v"(tid8_)); const int tid = tid8_, lane = tid8_ & 63;
    {
        typedef float f4 __attribute__((ext_vector_type(4)));
        constexpr int RT_PITCH = 528, RT_HALF = 48 * RT_PITCH, RT_BUF = 2 * RT_HALF;
        LAS float* lg = (LAS float*)(L + 2 * RT_BUF + wave * 3072);
        LAS int* hist = (LAS int*)(L + HIST_OFF); LAS int* basee = (LAS int*)(L + BASE_OFF);
        const int n = lane & 15, kq = lane >> 4;
        for (int chunk = vcu; chunk < T / 128; chunk += G) {
            __syncthreads(); if (tid < 32) hist[tid] = 0; __syncthreads();
            const int tok0 = chunk * 128 + wave * 16;
            const bf16* xp = X2B + (size_t)(tok0 + n) * DM + 8 * kq;
            f4 acc0 = {0.f, 0.f, 0.f, 0.f}, acc1 = acc0, acc2 = acc0; float ss = 0.f;
            v4u wreg[6], xv[8], xn[8];
#define RT_WLOAD(sl) do { _Pragma("unroll") for (int i_ = 0; i_ < 6; ++i_) { const int c_ = tid + 512 * i_, wh_ = c_ / 1536, cc_ = c_ % 1536, row_ = cc_ >> 5, part_ = cc_ & 31; \
                wreg[i_] = *(const v4u*)((wh_ ? WRL : WRH) + (size_t)row_ * DM + (sl) * 256 + part_ * 8); } } while (0)
#define RT_WSTORE(bufb) do { _Pragma("unroll") for (int i_ = 0; i_ < 6; ++i_) { const int c_ = tid + 512 * i_, wh_ = c_ / 1536, cc_ = c_ % 1536, row_ = cc_ >> 5, part_ = cc_ & 31; \
                *(LAS v4u*)(L + (bufb) * RT_BUF + wh_ * RT_HALF + row_ * RT_PITCH + part_ * 16) = wreg[i_]; } } while (0)
            RT_WLOAD(0);
#pragma unroll
            for (int st = 0; st < 8; ++st) xv[st] = *(const v4u*)(xp + 32 * st);
#pragma unroll 1
            for (int sl = 0; sl < 8; ++sl) {
                RT_WSTORE(sl & 1);
                if (sl < 7) { RT_WLOAD(sl + 1);
#pragma unroll
                    for (int st = 0; st < 8; ++st) xn[st] = *(const v4u*)(xp + (sl + 1) * 256 + 32 * st); }
                __syncthreads();
                const LAS unsigned char* wb = L + (sl & 1) * RT_BUF + n * RT_PITCH + kq * 16;
#pragma unroll
                for (int st = 0; st < 8; ++st) {
                    const v4u xw = xv[st]; const bf16x8 xh = __builtin_bit_cast(bf16x8, xw);
#pragma unroll
                    for (int k = 0; k < 4; ++k) { const float lo = __uint_as_float(xw[k] << 16), hi_ = __uint_as_float(xw[k] & 0xffff0000u); ss += lo * lo + hi_ * hi_; }
                    { const bf16x8 wh = *(const LAS bf16x8*)(wb + st * 64), wl = *(const LAS bf16x8*)(wb + RT_HALF + st * 64);
                      acc0 = __builtin_amdgcn_mfma_f32_16x16x32_bf16(wh, xh, acc0, 0, 0, 0); acc0 = __builtin_amdgcn_mfma_f32_16x16x32_bf16(wl, xh, acc0, 0, 0, 0); }
                    { const bf16x8 wh = *(const LAS bf16x8*)(wb + 16 * RT_PITCH + st * 64), wl = *(const LAS bf16x8*)(wb + RT_HALF + 16 * RT_PITCH + st * 64);
                      acc1 = __builtin_amdgcn_mfma_f32_16x16x32_bf16(wh, xh, acc1, 0, 0, 0); acc1 = __builtin_amdgcn_mfma_f32_16x16x32_bf16(wl, xh, acc1, 0, 0, 0); }
                    { const bf16x8 wh = *(const LAS bf16x8*)(wb + 32 * RT_PITCH + st * 64), wl = *(const LAS bf16x8*)(wb + RT_HALF + 32 * RT_PITCH + st * 64);
                      acc2 = __builtin_amdgcn_mfma_f32_16x16x32_bf16(wh, xh, acc2, 0, 0, 0); acc2 = __builtin_amdgcn_mfma_f32_16x16x32_bf16(wl, xh, acc2, 0, 0, 0); }
                }
                if (sl < 7) {
#pragma unroll
                    for (int st = 0; st < 8; ++st) xv[st] = xn[st]; }
            }
#undef RT_WLOAD
#undef RT_WSTORE
            ss += __shfl_xor(ss, 16); ss += __shfl_xor(ss, 32);
            const float rstd = __builtin_amdgcn_rsqf(ss * (1.f / DM) + EPS);
#pragma unroll
            for (int r = 0; r < 4; ++r) { lg[n * 48 + 4 * kq + r] = acc0[r] * rstd; lg[n * 48 + 16 + 4 * kq + r] = acc1[r] * rstd; lg[n * 48 + 32 + 4 * kq + r] = acc2[r] * rstd; }
            LDS_WAIT(); asm volatile("" ::: "memory");
            int e1 = 0, e2 = 0, lp1 = 0, lp2 = 0; float w1 = 0.f, w2 = 0.f;
            if (lane < 16) {
                const LAS float* q = lg + lane * 48;
                float gl[4];
#pragma unroll
                for (int j = 0; j < 4; ++j) gl[j] = q[32 + j] + p_b_rg[j];
                int gi = 0; float gm = gl[0];
#pragma unroll
                for (int j = 1; j < 4; ++j) if (gl[j] > gm) { gm = gl[j]; gi = j; }
                float den = 0.f;
#pragma unroll
                for (int j = 0; j < 4; ++j) den += __expf(gl[j] - gm);
                const float pg = 1.0f / den;
                float el[8];
#pragma unroll
                for (int j = 0; j < 8; ++j) el[j] = q[8 * gi + j] + p_b_re[8 * gi + j];
                int i1 = 0; float v1 = el[0];
#pragma unroll
                for (int j = 1; j < 8; ++j) if (el[j] > v1) { v1 = el[j]; i1 = j; }
                int i2 = -1; float v2 = -3.0e38f;
#pragma unroll
                for (int j = 0; j < 8; ++j) if (j != i1 && el[j] > v2) { v2 = el[j]; i2 = j; }
                const float ex = __expf(v2 - v1); w1 = pg / (1.0f + ex); w2 = pg * ex / (1.0f + ex);
                e1 = 8 * gi + i1; e2 = 8 * gi + i2;
                lp1 = atomicAdd((int*)(hist + e1), 1); lp2 = atomicAdd((int*)(hist + e2), 1);
            }
            __syncthreads();
            if (tid < 32) { const int c = hist[tid]; int b = 0; if (c > 0) b = (int)__hip_atomic_fetch_add((unsigned*)(ctl + CW_CNT + 64 * tid), (unsigned)c, __ATOMIC_RELAXED, __HIP_MEMORY_SCOPE_AGENT); basee[tid] = b; }
            __syncthreads();
            if (lane < 16) { const int tok = tok0 + lane;
                const int i1 = e1 * CAP + basee[e1] + lp1, i2 = e2 * CAP + basee[e2] + lp2;
                TOKL[i1] = tok; SLOTL[i1] = 2 * tok; WL[i1] = w1; RSL[i1] = rstd;
                TOKL[i2] = tok; SLOTL[i2] = 2 * tok + 1; WL[i2] = w2; RSL[i2] = rstd; }
        }
    }
    }
    xcd_barrier(bar);

    LAS int* tb = (LAS int*)(L + TB_OFF);
    if (threadIdx.x == 0) { int acc = 0; for (int e = 0; e < NEXP; ++e) { tb[e] = acc; const unsigned c = __hip_atomic_load(ctl + CW_CNT + 64 * e, RLX_AGENT); acc += (int)((c + 255u) >> 8); } tb[NEXP] = acc; }
    __syncthreads();
    const int NT = __builtin_amdgcn_readfirstlane(tb[NEXP]);
    PH(9) {
        pg8::Gemm g{X28, W1, 0, DM, DM / 2}; pg8::MoeOrder S{tb, NT, G, vcu, TOKL, (size_t)2048 * 2048};
        pg8::EpiSwiglu E{RSL, (unsigned char*)HB, L};
        pg8::gemm_phase<pg8::EpiSwiglu, pg8::MoeOrder, true, true, 0, 0x79797979u>(L, g, S, E);
    }
    xcd_barrier(bar);
    PH(10) {
        pg8::Gemm g{HB, W2, 0, DM, 512}; pg8::MoeOrder S{tb, NT, G, vcu, nullptr, (size_t)2048 * 1024};
        pg8::EpiDown E{SLOTL, WL, (unsigned char*)YB, L};
        pg8::gemm_phase<pg8::EpiDown, pg8::MoeOrder, false, true, 0, 0x79797979u>(L, g, S, E);
    }
    xcd_barrier(bar);

    PH(11) {
    int tid11_ = threadIdx.x; asm volatile("" : "+v"(tid11_)); const int lane11_ = tid11_ & 63;
    for (int m = gw; m < T; m += NGW) {
        GAS f32x4* xr = (GAS f32x4*)(args.out + (size_t)m * DM) + lane11_;
        const GAS unsigned long long* x2 = (const GAS unsigned long long*)(X2B + (size_t)m * DM) + lane11_;
        const GAS unsigned* y0 = (const GAS unsigned*)((const unsigned char*)YB + (size_t)(2 * m) * DM) + lane11_; const GAS unsigned* y1 = (const GAS unsigned*)((const unsigned char*)YB + (size_t)(2 * m + 1) * DM) + lane11_;
        f32x4 v[8]; float s = 0.f;
#pragma unroll
        for (int j = 0; j < 8; ++j) { const unsigned long long c = x2[64 * j]; const int a = (int)y0[64 * j], b = (int)y1[64 * j];
            v[j].x = __uint_as_float((unsigned)c << 16) + (__builtin_amdgcn_cvt_f32_fp8(a, 0) + __builtin_amdgcn_cvt_f32_fp8(b, 0));
            v[j].y = __uint_as_float((unsigned)c & 0xffff0000u) + (__builtin_amdgcn_cvt_f32_fp8(a, 1) + __builtin_amdgcn_cvt_f32_fp8(b, 1));
            v[j].z = __uint_as_float((unsigned)(c >> 32) << 16) + (__builtin_amdgcn_cvt_f32_fp8(a, 2) + __builtin_amdgcn_cvt_f32_fp8(b, 2));
            v[j].w = __uint_as_float((unsigned)(c >> 32) & 0xffff0000u) + (__builtin_amdgcn_cvt_f32_fp8(a, 3) + __builtin_amdgcn_cvt_f32_fp8(b, 3));
            s += (v[j].x * v[j].x + v[j].y * v[j].y) + (v[j].z * v[j].z + v[j].w * v[j].w); }
        const float rstd = __builtin_amdgcn_rsqf(wave_sum(s) * (1.f / DM) + EPS);
        const GAS f32x4* gf = (const GAS f32x4*)p_g_final + lane11_;
#pragma unroll
        for (int j = 0; j < 8; ++j) { const f32x4 gg = gf[64 * j]; xr[64 * j] = v[j] * rstd * gg; }
    }
    }
}

extern "C" void kernel_launch(void* const* d_in, const int* in_sizes, int n_in, void* d_out, int out_size, void* d_ws, size_t ws_size, hipStream_t stream) {
    static int grid = 0;
    if (grid == 0) {
        if (n_in != 24 || in_sizes[0] != T * DM || out_size != T * DM || ws_size < WS_END) { fprintf(stderr, "kernel_launch: unexpected shapes (n_in %d, in0 %d, out %d, ws %zu); nothing launched\n", n_in, n_in > 0 ? in_sizes[0] : -1, out_size, ws_size); grid = -1; return; }
        int dev = 0, cus = 0, per_cu = 0;
        if (hipGetDevice(&dev) != hipSuccess || hipDeviceGetAttribute(&cus, hipDeviceAttributeMultiprocessorCount, dev) != hipSuccess) { fprintf(stderr, "kernel_launch: device query failed\n"); grid = -1; return; }
        if (hipFuncSetAttribute((const void*)fwd_kernel, hipFuncAttributeMaxDynamicSharedMemorySize, LDS_BYTES) != hipSuccess) { fprintf(stderr, "kernel_launch: hipFuncSetAttribute failed\n"); grid = -1; return; }
        if (hipOccupancyMaxActiveBlocksPerMultiprocessor(&per_cu, (const void*)fwd_kernel, NWAVES * 64, LDS_BYTES) != hipSuccess || per_cu < 1)
            fprintf(stderr, "kernel_launch: note: occupancy query reports %d workgroups per CU\n", per_cu);
        (void)hipGetLastError();
        grid = cus;
    }
    if (grid < 0) return;
    if (hipMemsetAsync((char*)d_ws + WS_CTL, 0, CTL_ZERO_BYTES, stream) != hipSuccess) { fprintf(stderr, "kernel_launch: memset failed\n"); return; }
    Args a{};
    for (int i = 0; i < 24; ++i) a.in[i] = (const float*)d_in[i];
    a.out = (float*)d_out; a.ws = (unsigned char*)d_ws;
    hipLaunchKernelGGL(fwd_kernel, dim3(grid), dim3(NWAVES * 64), LDS_BYTES, stream, a);
    const hipError_t le = hipPeekAtLastError();
    if (le != hipSuccess) fprintf(stderr, "kernel_launch: launch failed: %s\n", hipGetErrorName(le));
}
```

```cpp
#include <hip/hip_runtime.h>
#include <cstdio>
#include <cstdint>

__device__ __forceinline__ int shx_lane_() { unsigned z = 0u; asm volatile("" : "+v"(z)); return (int)__builtin_amdgcn_mbcnt_hi(~0u, __builtin_amdgcn_mbcnt_lo(~0u, z)); }
__device__ __forceinline__ float shx_(float v, int m) { return __int_as_float(__builtin_amdgcn_ds_bpermute((shx_lane_() ^ m) << 2, __float_as_int(v))); }
__device__ __forceinline__ int shx_(int v, int m) { return __builtin_amdgcn_ds_bpermute((shx_lane_() ^ m) << 2, v); }
#define __shfl_xor(v, m) shx_((v), (m))

constexpr int BATCH = 2, SEQ = 16384, DM = 2048, T = BATCH * SEQ;
constexpr int LDP = 9216;
constexpr int PC_Q = 0, PC_K = 1024, PC_V = 2048, PC_U = 3072, PC_VG = 4096, PC_GS = 5120, PC_GG = 7168;
constexpr int NMEM = 256, NEXP = 32, CAP = 32768;
constexpr float EPS = 1e-6f;

namespace pg8 {
#define PG8_LAS __attribute__((address_space(3)))
typedef unsigned short bf16_t;
typedef short bf16x8 __attribute__((ext_vector_type(8)));
typedef float f32x4 __attribute__((ext_vector_type(4)));
typedef float f32x2 __attribute__((ext_vector_type(2)));
typedef unsigned u32x4 __attribute__((ext_vector_type(4)));
typedef long i64x2 __attribute__((ext_vector_type(2)));
typedef int i32x4 __attribute__((ext_vector_type(4)));
typedef int i32x8 __attribute__((ext_vector_type(8)));
typedef unsigned u32x2 __attribute__((ext_vector_type(2)));
constexpr int PG8_RS_OFF = 131072 + 2048 + 2048, PG8_SW_OFF = 131072 + 2048 + 4096;
constexpr int PG8_IDX_OFF = 131072 + 2048;
constexpr int BM = 256, BK = 64, HALF = 128, HTB = HALF * BK * 2  , STAGE_BYTES = 8 * HTB, NXCD = 8, WGM = 8;

__host__ __device__ __forceinline__ int lds_byte(int r, int c) { const int st = (r >> 4) * 2 + (c >> 5), rr = r & 15, cc = c & 31, ob = rr * 64 + cc * 2; return st * 1024 + (ob ^ (((ob >> 9) & 1) << 5)); }
__host__ __device__ __forceinline__ void stage_rc(int b, int& R, int& C) { const int st = b / 1024, sb = b % 1024, swz = sb ^ (((sb >> 9) & 1) << 5); R = (st >> 1) * 16 + swz / 64; C = (st & 1) * 32 + (swz % 64) / 2; }
__host__ __device__ __forceinline__ int perm32(int rho) { const int n = rho >> 4, i = rho & 15; return 8 * (i >> 2) + 4 * n + (i & 3); }

struct Unit { int pm, pn, e, lo, par; };
struct Gemm { const bf16_t* A; const bf16_t* Bt; int M, N, K; };

struct StaticOrder {
    int nM, nN, nwg, G, c, wgm;
    __host__ __device__ void init(int M, int N, int G_, int c_, int wgm_ = 2) { nM = M / BM; nN = N / BM; nwg = nM * nN; G = G_; c = c_; wgm = wgm_; }
    __host__ __device__ bool next(int i, Unit& u) const {
        const long L = (long)i * G + c; if (L >= nwg) return false;
        int wgid = (int)L; { const int q = nwg / NXCD, r = nwg % NXCD, xcd = wgid % NXCD, off = wgid / NXCD; wgid = (xcd < r ? xcd * (q + 1) : r * (q + 1) + (xcd - r) * q) + off; }
        const int nig = wgm * nN, gid = wgid / nig, fm = gid * wgm, gsz = (nM - fm) < wgm ? (nM - fm) : wgm;
        u.pm = fm + ((wgid % nig) % gsz); u.pn = (wgid % nig) / gsz; u.e = 0; u.lo = 0; return true;
    }
    __device__ __forceinline__ const char* aptr(const Gemm& g, const Unit& u) const { return (const char*)g.A + (size_t)u.pm * ((size_t)BM * g.K * 2); }
    __device__ __forceinline__ const char* bptr(const Gemm& g, const Unit& u) const { return (const char*)g.Bt + (size_t)u.pn * ((size_t)BM * g.K * 2); }
    __device__ __forceinline__ const int* arows(const Unit&) const { return nullptr; }
};
struct PairOrder {
    StaticOrder S; const bf16_t* A1; const bf16_t* B1;
    __device__ __forceinline__ bool next(int i, Unit& u) const { const bool ok = S.next(i >> 1, u); u.e = i & 1; return ok; }
    __device__ __forceinline__ const char* aptr(const Gemm& g, const Unit& u) const { return (const char*)(u.e ? A1 : g.A) + (size_t)u.pm * ((size_t)BM * g.K * 2); }
    __device__ __forceinline__ const char* bptr(const Gemm& g, const Unit& u) const { return (const char*)(u.e ? B1 : g.Bt) + (size_t)u.pn * ((size_t)BM * g.K * 2); }
    __device__ __forceinline__ const int* arows(const Unit&) const { return nullptr; }
};
struct MoeOrder {
    const PG8_LAS int* tb; int NT, G, c; const int* rows; size_t estride;
    __device__ __forceinline__ bool next(int i, Unit& u) const {
        const int L = i * G + c; if (L >= NT * 8) return false;
        const int tt = L >> 3; int e = 0;
#pragma unroll
        for (int k = 1; k < NEXP; ++k) e += (tb[k] <= tt) ? 1 : 0;
        e = __builtin_amdgcn_readfirstlane(e);
        const int tb_e = __builtin_amdgcn_readfirstlane(tb[e]);
        u.pm = tt; u.pn = L & 7; u.e = e; u.lo = e * CAP + (tt - tb_e) * BM; return true;
    }
    __device__ __forceinline__ const char* aptr(const Gemm& g, const Unit& u) const { return (const char*)g.A + (size_t)u.pm * ((size_t)BM * g.K * 2); }
    __device__ __forceinline__ const char* bptr(const Gemm& g, const Unit& u) const { return (const char*)g.Bt + (size_t)u.e * estride + (size_t)u.pn * ((size_t)BM * g.K * 2); }
    __device__ __forceinline__ const int* arows(const Unit& u) const { return rows + u.lo; }
};

__device__ __forceinline__ unsigned cvt_pk_bf16(float lo, float hi) { unsigned r; asm volatile("v_cvt_pk_bf16_f32 %0, %1, %2" : "=v"(r) : "v"(lo), "v"(hi)); return r; }
__device__ __forceinline__ float bf_lo(unsigned w) { return __uint_as_float(w << 16); }
__device__ __forceinline__ float bf_hi(unsigned w) { return __uint_as_float(w & 0xffff0000u); }
__device__ __forceinline__ float sigmoidf_(float x) { return __builtin_amdgcn_rcpf(1.0f + __builtin_amdgcn_exp2f(-1.4426950408889634f * x)); }
__device__ __forceinline__ float gelu_tanh(float x) { constexpr float GC1 = -2.0f * 0.7978845608028654f * 1.4426950408889634f, GC2 = 0.044715f * GC1;
    const float t = x * __builtin_fmaf(GC2, x * x, GC1); return x * __builtin_amdgcn_rcpf(1.0f + __builtin_amdgcn_exp2f(t)); }
__device__ __forceinline__ float sigmoid_pre(float zn) { return __builtin_amdgcn_rcpf(1.0f + __builtin_amdgcn_exp2f(zn)); }
__device__ __forceinline__ u32x4 pack8(const f32x4& a, const f32x4& b) { u32x4 w; w.x = cvt_pk_bf16(a[0], a[1]); w.y = cvt_pk_bf16(a[2], a[3]); w.z = cvt_pk_bf16(b[0], b[1]); w.w = cvt_pk_bf16(b[2], b[3]); return w; }

__device__ __forceinline__ unsigned pk_gate4(float a, float b, float c, float d) {
    const unsigned q0 = __float_as_uint(__builtin_fmaf(a, 255.f, 8388608.f)), q1 = __float_as_uint(__builtin_fmaf(b, 255.f, 8388608.f));
    const unsigned q2 = __float_as_uint(__builtin_fmaf(c, 255.f, 8388608.f)), q3 = __float_as_uint(__builtin_fmaf(d, 255.f, 8388608.f));
    return __builtin_amdgcn_perm(q1, q0, 0x0c0c0400u) | __builtin_amdgcn_perm(q3, q2, 0x04000c0cu); }
__device__ __forceinline__ float gate_b(unsigned w, int k) { return (float)((w >> (8 * k)) & 0xffu) * (1.0f / 255.0f); }
__device__ __forceinline__ float gate_q(unsigned w, int k) { return (float)((w >> (8 * k)) & 0xffu); }
constexpr int GATE_BYTE_OFF = 5120 * 2;
__device__ __forceinline__ unsigned pk_fp8x4(float a, float b, float c, float d) {
    a = __builtin_amdgcn_fmed3f(a, -448.f, 448.f); b = __builtin_amdgcn_fmed3f(b, -448.f, 448.f); c = __builtin_amdgcn_fmed3f(c, -448.f, 448.f); d = __builtin_amdgcn_fmed3f(d, -448.f, 448.f);
    int p = __builtin_amdgcn_cvt_pk_fp8_f32(a, b, 0, false); p = __builtin_amdgcn_cvt_pk_fp8_f32(c, d, p, true); return (unsigned)p; }
#define EPI_ROWS_BEGIN _Pragma("unroll") for (int ai = 0; ai < 2; ++ai) _Pragma("unroll") for (int m = 0; m < 4; ++m) {
#define EPI_ROWS_END }

struct EpiIn {
    static constexpr bool PERM = true;
    bf16_t* O; float* ssv;
    __device__ __forceinline__ void operator()(const f32x4 (&acc)[2][2][4][2], const Unit& u, int wr, int wc, int fr, int fq) const {
        const int pn = u.pn, mode = pn < 12 ? 0 : 1;
        const int row0 = u.pm * BM + wr * 64 + fr, col0 = pn * BM + wc * 32 + 8 * fq;
        EPI_ROWS_BEGIN
            const int row = row0 + ai * HALF + m * 16; bf16_t* rowp = O + (size_t)row * LDP + col0; float ss = 0.f;
#pragma unroll
            for (int bj = 0; bj < 2; ++bj) { f32x4 v0 = acc[ai][bj][m][0], v1 = acc[ai][bj][m][1];
                if (mode == 1) {
#pragma unroll
                    for (int k = 0; k < 4; ++k) { v0[k] = gelu_tanh(v0[k]); v1[k] = gelu_tanh(v1[k]); ss += v0[k] * v0[k] + v1[k] * v1[k]; }
                }
                *(u32x4*)(rowp + bj * HALF) = pack8(v0, v1); }
            if (pn >= 16 && pn < 20) { ss += __shfl_xor(ss, 16); ss += __shfl_xor(ss, 32); if (fq == 0) ssv[(size_t)row * 16 + (pn - 16) * 4 + wc] = ss; }
        EPI_ROWS_END
    }
};
struct EpiGateQ {
    static constexpr bool PERM = true;
    bf16_t* O;
    __device__ __forceinline__ void operator()(const f32x4 (&acc)[2][2][4][2], const Unit& u, int wr, int wc, int fr, int fq) const {
        int t_ = threadIdx.x; asm volatile("" : "+v"(t_));
        { const int wid_ = t_ >> 6, lane_ = t_ & 63; wr = wid_ >> 2; wc = wid_ & 3; fr = lane_ & 15; fq = lane_ >> 4; }
        const int row0 = u.pm * BM + wr * 64 + fr, colg = u.pn * BM + wc * 32 + 8 * fq;
        EPI_ROWS_BEGIN
            unsigned char* gp = (unsigned char*)(O + (size_t)(row0 + ai * HALF + m * 16) * LDP) + GATE_BYTE_OFF + colg;
#pragma unroll
            for (int bj = 0; bj < 2; ++bj) { f32x4 v0 = acc[ai][bj][m][0], v1 = acc[ai][bj][m][1];
#pragma unroll
                for (int k = 0; k < 4; ++k) { v0[k] = sigmoid_pre(v0[k]); v1[k] = sigmoid_pre(v1[k]); }
                u32x2 q8; q8.x = pk_gate4(v0[0], v0[1], v0[2], v0[3]); q8.y = pk_gate4(v1[0], v1[1], v1[2], v1[3]);
                *(u32x2*)(gp + bj * HALF) = q8; }
        EPI_ROWS_END
    }
};
struct EpiPlain {
    static constexpr bool PERM = true;
    bf16_t* O; int ldc;
    __device__ __forceinline__ void operator()(const f32x4 (&acc)[2][2][4][2], const Unit& u, int wr, int wc, int fr, int fq) const {
        const int row0 = u.pm * BM + wr * 64 + fr, col0 = u.pn * BM + wc * 32 + 8 * fq;
        EPI_ROWS_BEGIN
            bf16_t* rowp = O + (size_t)(row0 + ai * HALF + m * 16) * ldc + col0;
#pragma unroll
            for (int bj = 0; bj < 2; ++bj) *(u32x4*)(rowp + bj * HALF) = pack8(acc[ai][bj][m][0], acc[ai][bj][m][1]);
        EPI_ROWS_END
    }
};
__device__ __forceinline__ unsigned pg8_listoff() { int t_ = threadIdx.x; asm volatile("" : "+v"(t_)); return (unsigned)((t_ & 63) * 4 + ((t_ >> 6) & 3) * 256); }
template <class T> struct HasPre { static constexpr bool value = false; };
template <class T> struct KeepAcc { static __device__ __forceinline__ bool get(const Unit&) { return false; } };
__device__ __forceinline__ float gate_ratio(float a, float b) { return a * __builtin_amdgcn_rcpf(fmaxf(b, 1e-20f)); }
struct EpiGate3 {
    static constexpr bool PERM = true;
    const bf16_t* P; bf16_t* MG;
    __device__ __forceinline__ void operator()(f32x4 (&acc)[2][2][4][2], const Unit& u, int wr, int wc, int fr, int fq) const {
        const int row0 = u.pm * BM + wr * 64 + fr, col0 = u.pn * BM + wc * 32 + 8 * fq;
        if (u.e == 0) {
            u32x2 gs[2][4][2], gg[2][4][2];
#pragma unroll
            for (int ai = 0; ai < 2; ++ai)
#pragma unroll
                for (int m = 0; m < 4; ++m)
#pragma unroll
                    for (int bj = 0; bj < 2; ++bj) { const unsigned char* gp = (const unsigned char*)(P + (size_t)(row0 + ai * HALF + m * 16) * LDP) + GATE_BYTE_OFF + col0 + bj * HALF;
                        gs[ai][m][bj] = *(const u32x2*)gp; gg[ai][m][bj] = *(const u32x2*)(gp + 2048); }
#pragma unroll
            for (int ai = 0; ai < 2; ++ai)
#pragma unroll
                for (int m = 0; m < 4; ++m)
#pragma unroll
                    for (int bj = 0; bj < 2; ++bj) { const u32x2 a = gs[ai][m][bj], b = gg[ai][m][bj]; f32x4& v0 = acc[ai][bj][m][0]; f32x4& v1 = acc[ai][bj][m][1];
#pragma unroll
                        for (int k = 0; k < 4; ++k) { v0[k] *= gate_q(a.x, k) * __builtin_amdgcn_rcpf(fmaxf(gate_q(b.x, k), 255e-20f)); v1[k] *= gate_q(a.y, k) * __builtin_amdgcn_rcpf(fmaxf(gate_q(b.y, k), 255e-20f)); } }
        } else {
            u32x2 gg[2][4][2];
#pragma unroll
            for (int ai = 0; ai < 2; ++ai)
#pragma unroll
                for (int m = 0; m < 4; ++m)
#pragma unroll
                    for (int bj = 0; bj < 2; ++bj) gg[ai][m][bj] = *(const u32x2*)((const unsigned char*)(P + (size_t)(row0 + ai * HALF + m * 16) * LDP) + GATE_BYTE_OFF + 2048 + col0 + bj * HALF);
#pragma unroll
            for (int ai = 0; ai < 2; ++ai)
#pragma unroll
                for (int m = 0; m < 4; ++m)
#pragma unroll
                    for (int bj = 0; bj < 2; ++bj) { const u32x2 b = gg[ai][m][bj]; f32x4 v0 = acc[ai][bj][m][0], v1 = acc[ai][bj][m][1];
#pragma unroll
                        for (int k = 0; k < 4; ++k) { v0[k] *= fmaxf(gate_b(b.x, k), 1e-20f); v1[k] *= fmaxf(gate_b(b.y, k), 1e-20f); }
                        *(u32x4*)(MG + (size_t)(row0 + ai * HALF + m * 16) * DM + col0 + bj * HALF) = pack8(v0, v1); }
        }
    }
};
template <> struct KeepAcc<EpiGate3> { static __device__ __forceinline__ bool get(const Unit& u) { return u.e == 0; } };
struct EpiRes {
    static constexpr bool PERM = true;
    const bf16_t* XN; const float* XINV; bf16_t* XB; float* SS;
    __device__ __forceinline__ void operator()(const f32x4 (&acc)[2][2][4][2], const Unit& u, int wr, int wc, int fr, int fq) const {
        const int row0 = u.pm * BM + wr * 64 + fr, col0 = u.pn * BM + wc * 32 + 8 * fq;
        u32x4 xv[2][4][2]; float iv[2][4];
#pragma unroll
        for (int ai = 0; ai < 2; ++ai)
#pragma unroll
            for (int m = 0; m < 4; ++m) { const int row = row0 + ai * HALF + m * 16; iv[ai][m] = XINV[row];
#pragma unroll
                for (int bj = 0; bj < 2; ++bj) xv[ai][m][bj] = *(const u32x4*)(XN + (size_t)row * DM + col0 + bj * HALF); }
#pragma unroll
        for (int ai = 0; ai < 2; ++ai)
#pragma unroll
            for (int m = 0; m < 4; ++m) { const int row = row0 + ai * HALF + m * 16; float ss = 0.f; const float sc = iv[ai][m];
#pragma unroll
                for (int bj = 0; bj < 2; ++bj) { const size_t off = (size_t)row * DM + col0 + bj * HALF; const u32x4 p = xv[ai][m][bj];
                    f32x4 v0 = acc[ai][bj][m][0], v1 = acc[ai][bj][m][1];
                    v0[0] += bf_lo(p.x) * sc; v0[1] += bf_hi(p.x) * sc; v0[2] += bf_lo(p.y) * sc; v0[3] += bf_hi(p.y) * sc;
                    v1[0] += bf_lo(p.z) * sc; v1[1] += bf_hi(p.z) * sc; v1[2] += bf_lo(p.w) * sc; v1[3] += bf_hi(p.w) * sc;
                    *(u32x4*)(XB + off) = pack8(v0, v1);
#pragma unroll
                    for (int k = 0; k < 4; ++k) ss += v0[k] * v0[k] + v1[k] * v1[k]; }
                ss += __shfl_xor(ss, 16); ss += __shfl_xor(ss, 32); if (fq == 0) SS[(size_t)row * 32 + u.pn * 4 + wc] = ss; }
    }
};
struct EpiResB {
    static constexpr bool PERM = true;
    const bf16_t* XI; bf16_t* XB; unsigned char* X8;
    __device__ __forceinline__ void operator()(const f32x4 (&acc)[2][2][4][2], const Unit& u, int wr, int wc, int fr, int fq) const {
        const int row0 = u.pm * BM + wr * 64 + fr, col0 = u.pn * BM + wc * 32 + 8 * fq;
        u32x4 p[2][4][2];
#pragma unroll
        for (int ai = 0; ai < 2; ++ai)
#pragma unroll
            for (int m = 0; m < 4; ++m)
#pragma unroll
                for (int bj = 0; bj < 2; ++bj) p[ai][m][bj] = *(const u32x4*)(XI + (size_t)(row0 + ai * HALF + m * 16) * DM + col0 + bj * HALF);
#pragma unroll
        for (int ai = 0; ai < 2; ++ai)
#pragma unroll
            for (int m = 0; m < 4; ++m)
#pragma unroll
                for (int bj = 0; bj < 2; ++bj) { const size_t off = (size_t)(row0 + ai * HALF + m * 16) * DM + col0 + bj * HALF; const u32x4 pp = p[ai][m][bj];
                    f32x4 v0 = acc[ai][bj][m][0], v1 = acc[ai][bj][m][1];
                    v0[0] += bf_lo(pp.x); v0[1] += bf_hi(pp.x); v0[2] += bf_lo(pp.y); v0[3] += bf_hi(pp.y);
                    v1[0] += bf_lo(pp.z); v1[1] += bf_hi(pp.z); v1[2] += bf_lo(pp.w); v1[3] += bf_hi(pp.w);
                    *(u32x4*)(XB + off) = pack8(v0, v1);
                    u32x2 q8; q8.x = pk_fp8x4(v0[0], v0[1], v0[2], v0[3]); q8.y = pk_fp8x4(v1[0], v1[1], v1[2], v1[3]); *(u32x2*)(X8 + off) = q8; }
    }
};
struct EpiRowScale {
    static constexpr bool PERM = true;
    const float* SS; bf16_t* O; int ldc;
    __device__ __forceinline__ void operator()(const f32x4 (&acc)[2][2][4][2], const Unit& u, int wr, int wc, int fr, int fq) const {
        const int row0 = u.pm * BM + wr * 64 + fr, col0 = u.pn * BM + wc * 32 + 8 * fq;
#pragma unroll
        for (int ai = 0; ai < 2; ++ai) {
            f32x4 sp[4][2];
#pragma unroll
            for (int m = 0; m < 4; ++m) { const f32x4* p = (const f32x4*)(SS + (size_t)(row0 + ai * HALF + m * 16) * 32) + 2 * fq; sp[m][0] = p[0]; sp[m][1] = p[1]; }
#pragma unroll
            for (int m = 0; m < 4; ++m) { const int row = row0 + ai * HALF + m * 16; const f32x4 s = sp[m][0] + sp[m][1];
                float t = (s[0] + s[1]) + (s[2] + s[3]); t += __shfl_xor(t, 16); t += __shfl_xor(t, 32);
                const float rs = __builtin_amdgcn_rsqf(t * (1.0f / DM) + EPS);
                bf16_t* rowp = O + (size_t)row * ldc + col0;
#pragma unroll
                for (int bj = 0; bj < 2; ++bj) *(u32x4*)(rowp + bj * HALF) = pack8(acc[ai][bj][m][0] * rs, acc[ai][bj][m][1] * rs); }
        }
    }
};
struct EpiSwiglu {
    static constexpr bool PERM = true;
    const float* rsl; unsigned char* H; PG8_LAS unsigned char* L;
    __device__ __forceinline__ void pre(const Unit& u, int wid, int lane) const {
        __builtin_amdgcn_raw_ptr_buffer_load_lds(__builtin_amdgcn_make_buffer_rsrc((void*)rsl, (short)0, 0x7fffffff, 0x00020000), (PG8_LAS void*)(L + PG8_RS_OFF + u.par * 1024 + (wid & 3) * 256), 4,
                                                  pg8_listoff(), (unsigned)u.lo * 4u, 0, 0); }
    __device__ __forceinline__ void operator()(const f32x4 (&acc)[2][2][4][2], const Unit& u, int wr, int wc, int fr, int fq) const {
        int t_ = threadIdx.x; asm volatile("" : "+v"(t_));
        { const int wid_ = t_ >> 6, lane_ = t_ & 63; wr = wid_ >> 2; wc = wid_ & 3; fr = lane_ & 15; fq = lane_ >> 4; }
        const int r0 = wr * 64 + fr, col0 = u.pn * HALF + wc * 32 + 8 * fq;
        float rsv[2][4];
#pragma unroll
        for (int ai = 0; ai < 2; ++ai)
#pragma unroll
            for (int m = 0; m < 4; ++m) rsv[ai][m] = *(const PG8_LAS float*)(L + PG8_RS_OFF + u.par * 1024 + (r0 + ai * HALF + m * 16) * 4);
        EPI_ROWS_BEGIN
            const int rt = r0 + ai * HALF + m * 16; const float rs = rsv[ai][m];
            f32x4 g0 = acc[ai][0][m][0] * rs, g1 = acc[ai][0][m][1] * rs, u0 = acc[ai][1][m][0] * rs, u1 = acc[ai][1][m][1] * rs;
#pragma unroll
            for (int k = 0; k < 4; ++k) { g0[k] = g0[k] * sigmoidf_(g0[k]) * u0[k]; g1[k] = g1[k] * sigmoidf_(g1[k]) * u1[k]; }
            u32x2 q8; q8.x = pk_fp8x4(g0[0], g0[1], g0[2], g0[3]); q8.y = pk_fp8x4(g1[0], g1[1], g1[2], g1[3]); *(u32x2*)(H + (size_t)(u.pm * BM + rt) * 1024 + col0) = q8;
        EPI_ROWS_END
    }
};
struct EpiDown {
    static constexpr bool PERM = true;
    const int* slotl; const float* wl; unsigned char* Y; PG8_LAS unsigned char* L;
    __device__ __forceinline__ void pre(const Unit& u, int wid, int lane) const {
        const void* src_ = (wid < 4) ? (const void*)slotl : (const void*)wl;
        __builtin_amdgcn_raw_ptr_buffer_load_lds(__builtin_amdgcn_make_buffer_rsrc((void*)src_, (short)0, 0x7fffffff, 0x00020000), (PG8_LAS void*)(L + PG8_SW_OFF + u.par * 2048 + wid * 256), 4,
                                                  pg8_listoff(), (unsigned)u.lo * 4u, 0, 0); }
    __device__ __forceinline__ void operator()(const f32x4 (&acc)[2][2][4][2], const Unit& u, int wr, int wc, int fr, int fq) const {
        int t_ = threadIdx.x; asm volatile("" : "+v"(t_));
        { const int wid_ = t_ >> 6, lane_ = t_ & 63; wr = wid_ >> 2; wc = wid_ & 3; fr = lane_ & 15; fq = lane_ >> 4; }
        const int r0 = wr * 64 + fr, col0 = u.pn * BM + wc * 32 + 8 * fq;
        int slv[2][4]; float wv[2][4];
#pragma unroll
        for (int ai = 0; ai < 2; ++ai)
#pragma unroll
            for (int m = 0; m < 4; ++m) { const PG8_LAS unsigned char* p_ = L + PG8_SW_OFF + u.par * 2048 + (r0 + ai * HALF + m * 16) * 4; slv[ai][m] = *(const PG8_LAS int*)p_; wv[ai][m] = *(const PG8_LAS float*)(p_ + 1024); }
        EPI_ROWS_BEGIN
            const int slot = slv[ai][m]; const float w = wv[ai][m];
            if (slot >= 0) { unsigned char* rowp = Y + (size_t)slot * DM + col0;
#pragma unroll
                for (int bj = 0; bj < 2; ++bj) { const f32x4 v0 = acc[ai][bj][m][0] * w, v1 = acc[ai][bj][m][1] * w;
                    u32x2 pk; pk.x = pk_fp8x4(v0[0], v0[1], v0[2], v0[3]); pk.y = pk_fp8x4(v1[0], v1[1], v1[2], v1[3]);
                    *(u32x2*)(rowp + bj * HALF) = pk; } }
        EPI_ROWS_END
    }
};

template <> struct HasPre<EpiSwiglu> { static constexpr bool value = true; };
template <> struct HasPre<EpiDown> { static constexpr bool value = true; };
__device__ __forceinline__ const char* pg8_uni(const char* p) { const unsigned long long v = (unsigned long long)p;
    return (const char*)(((unsigned long long)(unsigned)__builtin_amdgcn_readfirstlane((int)(v >> 32)) << 32) | (unsigned)__builtin_amdgcn_readfirstlane((int)v)); }
template <class Epi, class Sched, bool GATHER, bool F8 = false, int WFMT = 1, unsigned WSC = 0x7F7F7F7Fu>
__device__ __forceinline__ void gemm_phase(PG8_LAS unsigned char* lds, const Gemm g, const Sched& S, const Epi& E) {
    int tid_ = threadIdx.x; asm volatile("" : "+v"(tid_));
    const int tid = tid_, wid = __builtin_amdgcn_readfirstlane(tid >> 6), lane = tid & 63, wr = wid >> 2, wc = wid & 3, fr = lane & 15, fq = lane >> 4;
    const int K = g.K, nt = K / BK;
    unsigned voffA[2], voffB[2]; int rA[2]; unsigned cA2[2];
#pragma unroll
    for (int i = 0; i < 2; ++i) { int R, C; stage_rc(tid * 16 + i * 8192, R, C); const int Rb = Epi::PERM ? ((R & ~31) + perm32(R & 31)) : R;
        voffA[i] = (unsigned)(R * K + C) * 2u; voffB[i] = (unsigned)(Rb * K + C) * 2u; rA[i] = R; cA2[i] = (unsigned)C * 2u; }
    const size_t kstep = (size_t)(BK * 2);
    const char* const baseA = (const char*)g.A; const char* const baseB = (const char*)g.Bt;
    const __amdgpu_buffer_rsrc_t rsA = __builtin_amdgcn_make_buffer_rsrc((void*)g.A, (short)0, 0x7fffffff, 0x00020000), rsB = __builtin_amdgcn_make_buffer_rsrc((void*)g.Bt, (short)0, 0x7fffffff, 0x00020000);
    const size_t hstep = (size_t)HALF * K * 2;
    const unsigned ldsw = (unsigned)wid * 1024u;
    const int aoff = lds_byte(wr * 64 + fr, fq * 8), boff = lds_byte(wc * 32 + fr, fq * 8);
    unsigned vaC[2][2], vaN[2][2];
#define PG8_SA(b, h) (((b) * 2 + (h)) * HTB)
#define PG8_SB(b, h) ((4 + (b) * 2 + (h)) * HTB)
#define PG8_STAGE_R(bufoff, rs, basep, gbase, voff) do { const unsigned _so = (unsigned)__builtin_amdgcn_readfirstlane((int)(unsigned)((const char*)(gbase) - (basep))); _Pragma("unroll") for (int _i = 0; _i < 2; ++_i) \
        __builtin_amdgcn_raw_ptr_buffer_load_lds(rs, (PG8_LAS void*)(lds + (bufoff) + ldsw + _i * 8192), 16, (voff)[_i], _so, 0, 0); } while (0)
#define PG8_STAGE(bufoff, gbase, voff) PG8_STAGE_R(bufoff, rsB, baseB, gbase, voff)
#define PG8_STAGE_A(bufoff, h, abase, useNext) do { if constexpr (GATHER) { unsigned _v[2]; _v[0] = (useNext) ? vaN[h][0] : vaC[h][0]; _v[1] = (useNext) ? vaN[h][1] : vaC[h][1]; PG8_STAGE_R(bufoff, rsA, baseA, abase, _v); } \
        else { PG8_STAGE_R(bufoff, rsA, baseA, (abase) + (h) * hstep, voffA); } } while (0)
#define PG8_ROWS(rows, va) do { _Pragma("unroll") for (int _h = 0; _h < 2; ++_h) _Pragma("unroll") for (int _i = 0; _i < 2; ++_i) { const unsigned _t = (unsigned)(rows)[_h * HALF + rA[_i]]; va[_h][_i] = _t * (unsigned)(K * 2) + cA2[_i]; } } while (0)
#define PG8_IDX_DMA(un, par) __builtin_amdgcn_raw_ptr_buffer_load_lds(rsR, (PG8_LAS void*)(lds + PG8_IDX_OFF + (par) * 1024 + (wid & 3) * 256), 4, pg8_listoff(), (unsigned)(un).lo * 4u, 0, 0)
#define PG8_IDX_RD(va, par) do { _Pragma("unroll") for (int _h = 0; _h < 2; ++_h) _Pragma("unroll") for (int _i = 0; _i < 2; ++_i) { \
        const unsigned _t = *(const PG8_LAS unsigned*)(lds + PG8_IDX_OFF + (par) * 1024 + (_h * HALF + rA[_i]) * 4); va[_h][_i] = _t * (unsigned)(K * 2) + cA2[_i]; } } while (0)
#define PG8_LD8(p) __builtin_shufflevector(*(const PG8_LAS i32x4*)(p), *(const PG8_LAS i32x4*)((p) + 1024), 0, 1, 2, 3, 4, 5, 6, 7)
#define PG8_LDA(dst, b, h) do { if constexpr (F8) { _Pragma("unroll") for (int m = 0; m < 4; ++m) dst##8[m] = PG8_LD8(lds + PG8_SA(b, h) + aoff + m * 2048); } \
        else { _Pragma("unroll") for (int m = 0; m < 4; ++m) _Pragma("unroll") for (int k = 0; k < 2; ++k) dst[m][k] = *(const PG8_LAS bf16x8*)(lds + PG8_SA(b, h) + aoff + m * 2048 + k * 1024); } } while (0)
#define PG8_LDB(dst, b, h) do { if constexpr (F8) { _Pragma("unroll") for (int n = 0; n < 2; ++n) dst##8[n] = PG8_LD8(lds + PG8_SB(b, h) + boff + n * 2048); } \
        else { _Pragma("unroll") for (int n = 0; n < 2; ++n) _Pragma("unroll") for (int k = 0; k < 2; ++k) dst[n][k] = *(const PG8_LAS bf16x8*)(lds + PG8_SB(b, h) + boff + n * 2048 + k * 1024); } } while (0)
#define PG8_MMA(ai, bj, A_, B_) do { __builtin_amdgcn_s_setprio(1); _Pragma("unroll") for (int m = 0; m < 4; ++m) _Pragma("unroll") for (int n = 0; n < 2; ++n) { \
        if constexpr (F8) acc[ai][bj][m][n] = __builtin_amdgcn_mfma_scale_f32_16x16x128_f8f6f4(B_##8[n], A_##8[m], acc[ai][bj][m][n], WFMT  , 0  , 0, (int)WSC, 0, 0x7F7F7F7F); \
        else { _Pragma("unroll") for (int k = 0; k < 2; ++k) acc[ai][bj][m][n] = __builtin_amdgcn_mfma_f32_16x16x32_bf16(B_[n][k], A_[m][k], acc[ai][bj][m][n], 0, 0, 0); } } __builtin_amdgcn_s_setprio(0); } while (0)
#define PG8_WAIT_V(n) asm volatile("s_waitcnt vmcnt(" #n ")" ::: "memory")
#define PG8_WAIT_L(n) asm volatile("s_waitcnt lgkmcnt(" #n ")" ::: "memory")
#define PG8_BAR __builtin_amdgcn_s_barrier()
#define PG8_SCHED __builtin_amdgcn_sched_barrier(0)
    Unit cur, nxt; int ui = 0;
    if (!S.next(0, cur)) return;
    cur.par = 0;
    if constexpr (HasPre<Epi>::value) E.pre(cur, wid, lane);
    f32x4 acc[2][2][4][2];
#pragma unroll
    for (int a = 0; a < 2; ++a)
#pragma unroll
        for (int b = 0; b < 2; ++b)
#pragma unroll
            for (int m = 0; m < 4; ++m)
#pragma unroll
                for (int n = 0; n < 2; ++n) acc[a][b][m][n] = (f32x4){0.f, 0.f, 0.f, 0.f};
    bf16x8 At[4][2], B0[2][2], B1[2][2]; i32x8 At8[4], B08[2], B18[2];
    const char* cA = pg8_uni(GATHER ? (const char*)g.A : S.aptr(g, cur)); const char* cB = pg8_uni(S.bptr(g, cur));
    __amdgpu_buffer_rsrc_t rsR = rsA;
    if constexpr (GATHER) { const int* rows = S.arows(cur); PG8_ROWS(rows, vaC);
        rsR = __builtin_amdgcn_make_buffer_rsrc((void*)S.rows, (short)0, 0x7fffffff, 0x00020000);
        Unit n1_; if (S.next(1, n1_)) PG8_IDX_DMA(n1_, 1); }
    PG8_STAGE(PG8_SB(0, 0), cB, voffB); PG8_STAGE(PG8_SB(0, 1), cB + hstep, voffB); PG8_STAGE_A(PG8_SA(0, 0), 0, cA, false); PG8_STAGE_A(PG8_SA(0, 1), 1, cA, false);
    if (wr == 1) PG8_BAR;
    PG8_WAIT_V(2); PG8_BAR;
    PG8_STAGE(PG8_SB(1, 0), cB + kstep, voffB); PG8_STAGE_A(PG8_SA(1, 0), 0, cA + kstep, false); PG8_STAGE(PG8_SB(1, 1), cB + hstep + kstep, voffB);
    PG8_WAIT_V(6); PG8_BAR;
    for (;;) {
        const bool has_next = S.next(ui + 1, nxt);
        const char* nA = pg8_uni(GATHER ? cA : (has_next ? S.aptr(g, nxt) : cA)); const char* nB = pg8_uni(has_next ? S.bptr(g, nxt) : cB);
        if constexpr (GATHER) {
            if (has_next) { PG8_IDX_RD(vaN, (ui + 1) & 1); }
            else {
#pragma unroll
                for (int h = 0; h < 2; ++h) { vaN[h][0] = vaC[h][0]; vaN[h][1] = vaC[h][1]; } }
        }
        if constexpr (GATHER) { Unit n2_; if (S.next(ui + 2, n2_)) PG8_IDX_DMA(n2_, ui & 1); }
#pragma unroll 1
        for (int t = 0; t < nt; t += 2) {
            const bool last = (t == nt - 2);
            const char* a1 = cA + (size_t)(t + 1) * kstep;
            const char* a2 = last ? nA : cA + (size_t)(t + 2) * kstep; const char* b2 = last ? nB : cB + (size_t)(t + 2) * kstep;
            const char* a3 = a2 + kstep; const char* b3 = b2 + kstep;
            PG8_LDB(B0, 0, 0); PG8_LDB(B1, 0, 1); PG8_SCHED; PG8_LDA(At, 0, 0); PG8_STAGE_A(PG8_SA(1, 1), 1, a1, false);
            PG8_WAIT_V(8); PG8_WAIT_L(0); PG8_BAR; PG8_MMA(0, 0, At, B0); PG8_MMA(0, 1, At, B1); PG8_BAR; PG8_SCHED;
            PG8_LDA(At, 0, 1); PG8_STAGE(PG8_SB(0, 0), b2, voffB); PG8_STAGE(PG8_SB(0, 1), b2 + hstep, voffB); PG8_STAGE_A(PG8_SA(0, 0), 0, a2, last);
            PG8_WAIT_V(8); PG8_WAIT_L(0); PG8_BAR; PG8_MMA(1, 0, At, B0); PG8_MMA(1, 1, At, B1); PG8_BAR; PG8_SCHED;
            PG8_LDB(B0, 1, 0); PG8_LDB(B1, 1, 1); PG8_SCHED; PG8_LDA(At, 1, 0); PG8_STAGE_A(PG8_SA(0, 1), 1, a2, last);
            PG8_WAIT_V(8); PG8_WAIT_L(0); PG8_BAR; PG8_MMA(0, 0, At, B0); PG8_MMA(0, 1, At, B1); PG8_BAR; PG8_SCHED;
            PG8_LDA(At, 1, 1); PG8_STAGE(PG8_SB(1, 0), b3, voffB); PG8_STAGE(PG8_SB(1, 1), b3 + hstep, voffB); PG8_STAGE_A(PG8_SA(1, 0), 0, a3, last);
            PG8_WAIT_V(8); PG8_WAIT_L(0); PG8_BAR; PG8_MMA(1, 0, At, B0); PG8_MMA(1, 1, At, B1); PG8_BAR; PG8_SCHED;
        }
        if (wr == 0) PG8_BAR;
        E(acc, cur, wr, wc, fr, fq);
        if (!has_next) break;
        if (!KeepAcc<Epi>::get(cur)) {
#pragma unroll
        for (int a = 0; a < 2; ++a)
#pragma unroll
            for (int b = 0; b < 2; ++b)
#pragma unroll
                for (int m = 0; m < 4; ++m)
#pragma unroll
                    for (int n = 0; n < 2; ++n) acc[a][b][m][n] = (f32x4){0.f, 0.f, 0.f, 0.f};
        }
        cur = nxt; cA = nA; cB = nB; ++ui; cur.par = ui & 1;
        if constexpr (HasPre<Epi>::value) E.pre(cur, wid, lane);
        if constexpr (GATHER) {
#pragma unroll
            for (int h = 0; h < 2; ++h) { vaC[h][0] = vaN[h][0]; vaC[h][1] = vaN[h][1]; } }
        if (wr == 1) PG8_BAR;
    }
    PG8_WAIT_V(0);
    PG8_BAR;
#undef PG8_SA
#undef PG8_SB
#undef PG8_STAGE
#undef PG8_STAGE_R
#undef PG8_STAGE_A
#undef PG8_ROWS
#undef PG8_IDX_DMA
#undef PG8_IDX_RD
#undef PG8_LDA
#undef PG8_LD8
#undef PG8_LDB
#undef PG8_MMA
#undef PG8_WAIT_V
#undef PG8_WAIT_L
#undef PG8_BAR
#undef PG8_SCHED
}
}

namespace att {
typedef unsigned short bf16_t;
using bf16x8 = __attribute__((ext_vector_type(8))) short;
using s16x4  = __attribute__((ext_vector_type(4))) short;
using f32x16 = __attribute__((ext_vector_type(16))) float;
using f32x4  = __attribute__((ext_vector_type(4))) float;
using u32x4  = __attribute__((ext_vector_type(4))) unsigned;
#define KSWZ(row, colB) ((row) * 256 + ((colB) ^ (((row) & 7) << 4)))
#define SBAR() __builtin_amdgcn_sched_barrier(0)
__device__ __forceinline__ int crow(int r, int hi) { return (r & 3) + 8 * (r >> 2) + 4 * hi; }
__device__ __forceinline__ unsigned cvtpk(float lo, float hi) { unsigned r; asm volatile("v_cvt_pk_bf16_f32 %0, %1, %2" : "=v"(r) : "v"(lo), "v"(hi)); return r; }
__device__ __forceinline__ unsigned short f2bf(float f) { return (unsigned short)(cvtpk(f, 0.f) & 0xffffu); }
__device__ __forceinline__ float bf2f(unsigned short h) { return __uint_as_float((unsigned)h << 16); }
constexpr int SHM_V = 64 * 128 * 2, SHM_K = 64 * 128 * 2;

#define PK4(P, BASE, OUT) do { unsigned a0 = cvtpk(P[BASE + 0], P[BASE + 1]), a1 = cvtpk(P[BASE + 2], P[BASE + 3]);   \
    unsigned b0 = cvtpk(P[BASE + 4], P[BASE + 5]), b1 = cvtpk(P[BASE + 6], P[BASE + 7]);                              \
    auto r0 = __builtin_amdgcn_permlane32_swap(a0, b0, false, false); auto r1 = __builtin_amdgcn_permlane32_swap(a1, b1, false, false); \
    u32x4 w = {r0[0], r1[0], r0[1], r1[1]}; OUT = *reinterpret_cast<bf16x8*>(&w); } while (0)

__device__ __forceinline__ void qkt(f32x16& p0, f32x16& p1, const bf16_t* Ks, const bf16x8* qr, int r32, int hi) {
  p0 = f32x16{}; p1 = f32x16{};
#pragma unroll
  for (int d0 = 0; d0 < 8; ++d0) { int cb = (d0 * 16 + hi * 8) * 2;
    bf16x8 b0 = *reinterpret_cast<const bf16x8*>((const char*)Ks + KSWZ(r32, cb));
    bf16x8 b1 = *reinterpret_cast<const bf16x8*>((const char*)Ks + KSWZ(32 + r32, cb));
    p0 = __builtin_amdgcn_mfma_f32_32x32x16_bf16(b0, qr[d0], p0, 0, 0, 0);
    p1 = __builtin_amdgcn_mfma_f32_32x32x16_bf16(b1, qr[d0], p1, 0, 0, 0); }
}
__device__ __forceinline__ int v_st(int k, int c) { const int kk = (k & ~0xC) | ((k & 4) << 1) | ((k & 8) >> 1); return ((kk >> 3) * 4 + (c >> 5)) * 512 + ((kk & 7) * 32 + (c & 31)) * 2; }
__device__ __forceinline__ int v_rd_base(int lane) { return ((lane & 3) << 3) | (((lane >> 2) & 3) << 6) | (((lane >> 4) & 1) << 5) | (((lane >> 5) & 1) << 8); }
constexpr int v_rd_off(int d0, int ks, int half) { return d0 * 512 + ks * 4096 + half * 2048; }
template <int OFF> __device__ __forceinline__ s16x4 tr_read(int vb) {
  s16x4 r; asm volatile("ds_read_b64_tr_b16 %0, %1 offset:%2" : "=&v"(r) : "v"(vb), "i"(OFF) : "memory"); return r;
}
template <int D0> __device__ __forceinline__ void pv_one(f32x16& od, int vb, bf16x8 pa0, bf16x8 pa1, bf16x8 pa2, bf16x8 pa3) {
  const s16x4 l0 = tr_read<v_rd_off(D0, 0, 0)>(vb), h0 = tr_read<v_rd_off(D0, 0, 1)>(vb), l1 = tr_read<v_rd_off(D0, 1, 0)>(vb), h1 = tr_read<v_rd_off(D0, 1, 1)>(vb);
  const s16x4 l2 = tr_read<v_rd_off(D0, 2, 0)>(vb), h2 = tr_read<v_rd_off(D0, 2, 1)>(vb), l3 = tr_read<v_rd_off(D0, 3, 0)>(vb), h3 = tr_read<v_rd_off(D0, 3, 1)>(vb);
  asm volatile("s_waitcnt lgkmcnt(0)" ::: "memory"); SBAR();
#define PKV(L, H) (bf16x8){L[0], L[1], L[2], L[3], H[0], H[1], H[2], H[3]}
  od = __builtin_amdgcn_mfma_f32_32x32x16_bf16(pa0, PKV(l0, h0), od, 0, 0, 0);
  od = __builtin_amdgcn_mfma_f32_32x32x16_bf16(pa1, PKV(l1, h1), od, 0, 0, 0);
  od = __builtin_amdgcn_mfma_f32_32x32x16_bf16(pa2, PKV(l2, h2), od, 0, 0, 0);
  od = __builtin_amdgcn_mfma_f32_32x32x16_bf16(pa3, PKV(l3, h3), od, 0, 0, 0);
#undef PKV
}
__device__ __forceinline__ void pv_d0(f32x16* o, int vb, bf16x8 pa0, bf16x8 pa1, bf16x8 pa2, bf16x8 pa3) {
  pv_one<0>(o[0], vb, pa0, pa1, pa2, pa3); pv_one<1>(o[1], vb, pa0, pa1, pa2, pa3); pv_one<2>(o[2], vb, pa0, pa1, pa2, pa3); pv_one<3>(o[3], vb, pa0, pa1, pa2, pa3);
}
typedef __attribute__((address_space(3))) unsigned short lds_u16;
__device__ __forceinline__ void store_o_bf16(const f32x16* o, const float* rs, bf16_t* Ow, int ldo, int lane, lds_u16* stg) {
  const int r32 = lane & 31, hi = lane >> 5;
#pragma unroll
  for (int d0 = 0; d0 < 4; ++d0) {
#pragma unroll
    for (int r = 0; r < 16; ++r) stg[crow(r, hi) * 32 + r32] = f2bf(o[d0][r] * rs[r]);
    asm volatile("s_waitcnt lgkmcnt(0)" ::: "memory");
#pragma unroll
    for (int t = 0; t < 2; ++t) { const int c = lane + 64 * t, row = c >> 2, part = c & 3;
      const u32x4 v = *(const __attribute__((address_space(3))) u32x4*)(stg + row * 32 + part * 8);
      *(u32x4*)(Ow + (size_t)row * ldo + d0 * 32 + part * 8) = v; }
    asm volatile("s_waitcnt lgkmcnt(0)" ::: "memory");
  }
}

template <bool MASKED> __device__ __forceinline__ void sb_weights(f32x16& p0, f32x16& p1, float& CP, int dq, int hi) {
  constexpr float ZS = 0.08838834764831845f * 1.4426950408889634f;
  float om0[16], om1[16];
#pragma unroll
  for (int r = 0; r < 16; ++r) {
    { const float en = __builtin_amdgcn_exp2f(-fmaxf(p0[r] * ZS, -100.f)); const float be = __builtin_amdgcn_rcpf(1.0f + en); const float om = en * be;
      if (MASKED) { const bool valid = ((r & 3) + 8 * (r >> 2)) < dq; p0[r] = valid ? be : 0.f; om0[r] = valid ? om : 1.f; } else { p0[r] = be; om0[r] = om; } }
    { const float en = __builtin_amdgcn_exp2f(-fmaxf(p1[r] * ZS, -100.f)); const float be = __builtin_amdgcn_rcpf(1.0f + en); const float om = en * be;
      if (MASKED) { const bool valid = (32 + (r & 3) + 8 * (r >> 2)) < dq; p1[r] = valid ? be : 0.f; om1[r] = valid ? om : 1.f; } else { p1[r] = be; om1[r] = om; } }
  }
  float tg[8];
#pragma unroll
  for (int gi = 0; gi < 4; ++gi) {
    { const float e1 = om0[4 * gi + 2] * om0[4 * gi + 3], e0 = om0[4 * gi + 1] * e1; tg[gi] = om0[4 * gi] * e0; p0[4 * gi + 2] *= om0[4 * gi + 3]; p0[4 * gi + 1] *= e1; p0[4 * gi] *= e0; }
    { const float e1 = om1[4 * gi + 2] * om1[4 * gi + 3], e0 = om1[4 * gi + 1] * e1; tg[4 + gi] = om1[4 * gi] * e0; p1[4 * gi + 2] *= om1[4 * gi + 3]; p1[4 * gi + 1] *= e1; p1[4 * gi] *= e0; }
  }
  float offP[8]; float run = CP;
#pragma unroll
  for (int gi = 7; gi >= 0; --gi) {
    auto rr = __builtin_amdgcn_permlane32_swap(__float_as_uint(tg[gi]), __float_as_uint(tg[gi]), false, false);
    const float pt = hi ? __uint_as_float(rr[0]) : __uint_as_float(rr[1]);
    offP[gi] = hi ? run : run * pt;
    run *= tg[gi] * pt; }
  CP = run;
#pragma unroll
  for (int r = 0; r < 16; ++r) { p0[r] *= offP[r >> 2]; p1[r] *= offP[4 + (r >> 2)]; }
}

typedef __attribute__((address_space(3))) unsigned char lds_u8;
__device__ __forceinline__ void sb_unit(const bf16_t* __restrict__ P, bf16_t* __restrict__ OSB, int b, int hp, int qblk, char* lds, lds_u8* ldsL, volatile __attribute__((address_space(3))) int* flags, lds_u16* stg) {
  int tid_ = threadIdx.x; asm volatile("" : "+v"(tid_));
  const int tid = tid_, wid = __builtin_amdgcn_readfirstlane(tid >> 6), lane = tid & 63, r32 = lane & 31, hi = lane >> 5;
  const size_t rowbase = (size_t)b * SEQ; const int q0 = qblk * 128;
  const int hsel = wid >> 2, jw = wid & 3, h = 2 * hp + hsel;
  bf16x8 qr[8];
  const int ftile = wid >> 1, fhalf = wid & 1;
  const char* tsrc = (const char*)(P + rowbase * LDP + ((ftile >> 1) ? PC_V : PC_K) + (2 * hp + (ftile & 1)) * 128);
  unsigned soff[8];
#pragma unroll
  for (int i = 0; i < 8; ++i) { const int o = (fhalf * 8 + i) * 1024 + lane * 16;
    const int krow = o >> 8, kcolB = (o & 255) ^ ((krow & 7) << 4);
    const int sub = o >> 9, kk = (sub >> 2) * 8 + ((o & 511) >> 6), vc = (sub & 3) * 32 + (((o & 511) >> 1) & 31), vk = (kk & ~0xC) | ((kk & 4) << 1) | ((kk & 8) >> 1);
    soff[i] = (ftile >> 1) ? (unsigned)(vk * (LDP * 2) + vc * 2) : (unsigned)(krow * (LDP * 2) + kcolB); }
  const unsigned fdst = (unsigned)(ftile * 16384 + fhalf * 8192);
#define SB_DMA(stage, kt_) do { const char* src_ = tsrc + (size_t)(kt_) * (size_t)(64 * LDP * 2); \
    _Pragma("unroll") for (int i = 0; i < 8; ++i) __builtin_amdgcn_global_load_lds((const unsigned*)(src_ + soff[i]), (__attribute__((address_space(3))) unsigned*)(ldsL + (stage) * 65536 + fdst + i * 1024), 16, 0, 0); } while (0)
  f32x16 o[4] = {};
  float CP = 1.f; const int qpos = q0 + jw * 32 + r32; bool fin = false;
  int kt = qblk * 2 + 1, st = 0;
  SB_DMA(0, kt);
  { const bf16_t* Qw = P + (rowbase + q0 + jw * 32 + r32) * LDP + PC_Q + h * 128 + hi * 8;
#pragma unroll
    for (int d0 = 0; d0 < 8; ++d0) qr[d0] = *reinterpret_cast<const bf16x8*>(Qw + d0 * 16); }
  asm volatile("" :: "v"(qr[0]), "v"(qr[1]), "v"(qr[2]), "v"(qr[3]), "v"(qr[4]), "v"(qr[5]), "v"(qr[6]), "v"(qr[7]));
  for (int it = 0;; ++it) {
    if (it > 0) { int all = 1;
#pragma unroll
      for (int w = 0; w < 8; ++w) all &= flags[w];
      if (all) { asm volatile("s_waitcnt vmcnt(0)" ::: "memory"); break; } }
    if (kt > 0) { SB_DMA(st ^ 1, kt - 1); asm volatile("s_waitcnt vmcnt(8)" ::: "memory"); }
    else asm volatile("s_waitcnt vmcnt(0)" ::: "memory");
    __builtin_amdgcn_s_barrier();
    asm volatile("" ::: "memory");
    const int key0 = kt * 64;
    if (!fin && key0 < q0 + jw * 32 + 31) {
      const bf16_t* K_lds = (const bf16_t*)(lds + st * 65536 + hsel * 16384);
      const int vb0 = (int)(uintptr_t)(lds + st * 65536 + 32768 + hsel * 16384) + v_rd_base(lane);
      f32x16 p0, p1; qkt(p0, p1, K_lds, qr, r32, hi);
      if (key0 + 63 < q0 + jw * 32) sb_weights<false>(p0, p1, CP, 0, hi);
      else sb_weights<true>(p0, p1, CP, qpos - key0 - 4 * hi, hi);
      bf16x8 pa0, pa1, pa2, pa3;
      PK4(p0, 0, pa0); PK4(p0, 8, pa1); PK4(p1, 0, pa2); PK4(p1, 8, pa3);
      pv_d0(o, vb0, pa0, pa1, pa2, pa3);
      fin = __all(CP < 1.1754944e-38f);
    }
    if (lane == 0) flags[wid] = fin ? 1 : 0;
    asm volatile("s_waitcnt lgkmcnt(0)" ::: "memory");
    __builtin_amdgcn_s_barrier();
    asm volatile("" ::: "memory");
    if (kt == 0) break;
    --kt; st ^= 1;
  }
#undef SB_DMA
  float ones[16];
#pragma unroll
  for (int r = 0; r < 16; ++r) ones[r] = 1.0f;
  store_o_bf16(o, ones, OSB + (rowbase + q0 + jw * 32) * 1024 + h * 128, 1024, lane, stg + wid * 1024);
}

template <int D0> __device__ __forceinline__ void pv_one_t(f32x16& od, int vb, bf16x8 pa0, bf16x8 pa1, bf16x8 pa2, bf16x8 pa3) {
  const s16x4 l0 = tr_read<v_rd_off(D0, 0, 0)>(vb), h0 = tr_read<v_rd_off(D0, 0, 1)>(vb), l1 = tr_read<v_rd_off(D0, 1, 0)>(vb), h1 = tr_read<v_rd_off(D0, 1, 1)>(vb);
  const s16x4 l2 = tr_read<v_rd_off(D0, 2, 0)>(vb), h2 = tr_read<v_rd_off(D0, 2, 1)>(vb), l3 = tr_read<v_rd_off(D0, 3, 0)>(vb), h3 = tr_read<v_rd_off(D0, 3, 1)>(vb);
  asm volatile("s_waitcnt lgkmcnt(0)" ::: "memory"); SBAR();
#define PKV(L, H) (bf16x8){L[0], L[1], L[2], L[3], H[0], H[1], H[2], H[3]}
  od = __builtin_amdgcn_mfma_f32_32x32x16_bf16(PKV(l0, h0), pa0, od, 0, 0, 0);
  od = __builtin_amdgcn_mfma_f32_32x32x16_bf16(PKV(l1, h1), pa1, od, 0, 0, 0);
  od = __builtin_amdgcn_mfma_f32_32x32x16_bf16(PKV(l2, h2), pa2, od, 0, 0, 0);
  od = __builtin_amdgcn_mfma_f32_32x32x16_bf16(PKV(l3, h3), pa3, od, 0, 0, 0);
#undef PKV
}
__device__ __forceinline__ bf16x8 scale8(bf16x8 v, float f, f32x4 g0, f32x4 g1) {
  u32x4 w = *reinterpret_cast<u32x4*>(&v), o;
  o[0] = cvtpk(__uint_as_float(w[0] << 16) * (f * g0[0]), __uint_as_float(w[0] & 0xffff0000u) * (f * g0[1]));
  o[1] = cvtpk(__uint_as_float(w[1] << 16) * (f * g0[2]), __uint_as_float(w[1] & 0xffff0000u) * (f * g0[3]));
  o[2] = cvtpk(__uint_as_float(w[2] << 16) * (f * g1[0]), __uint_as_float(w[2] & 0xffff0000u) * (f * g1[1]));
  o[3] = cvtpk(__uint_as_float(w[3] << 16) * (f * g1[2]), __uint_as_float(w[3] & 0xffff0000u) * (f * g1[3]));
  return *reinterpret_cast<bf16x8*>(&o);
}
__device__ __forceinline__ void gm_unit2(const bf16_t* __restrict__ P, const float* __restrict__ SSV, const u32x4* __restrict__ WPA, const float* __restrict__ BSP,
                                         const float* __restrict__ GGM, bf16_t* __restrict__ OGM, int chunk, int gp, char* lds, float* rv) {
  int tid_ = threadIdx.x; asm volatile("" : "+v"(tid_));
  const int tid = tid_, wid = __builtin_amdgcn_readfirstlane(tid >> 6), lane = tid & 63, r32 = lane & 31, hi = lane >> 5;
  const int gsel = wid >> 2, w4 = wid & 3, g = 2 * gp + gsel, t = 32 * w4 + r32;
  const int sr = tid >> 4, sc = (tid & 15) * 8;
  const size_t t0 = (size_t)chunk * 128;
  char* ut = lds + 65536;
  const int vb0 = (int)(uintptr_t)lds + v_rd_base(lane);
  __syncthreads();
  { const int row = tid >> 2, part = tid & 3; const f32x4 v = *(const f32x4*)(SSV + (t0 + row) * 16 + part * 4); float s = (v[0] + v[1]) + (v[2] + v[3]);
    s += __shfl_xor(s, 1); s += __shfl_xor(s, 2); if (part == 0) rv[row] = __builtin_amdgcn_rsqf(s * (1.0f / 1024.0f) + EPS); }
  bf16x8 pa[2][4]; f32x4 ggv[2][2]; float bias;
  { bf16x8 vg[2][4], uu[8];
#pragma unroll
    for (int grp = 0; grp < 2; ++grp)
#pragma unroll
      for (int rr = 0; rr < 4; ++rr) vg[grp][rr] = *reinterpret_cast<const bf16x8*>(P + (t0 + rr * 32 + sr) * LDP + PC_VG + (2 * gp + grp) * 128 + sc);
#pragma unroll
    for (int i = 0; i < 8; ++i) { const int c = tid + 512 * i, row = c >> 5, part = c & 31; uu[i] = *reinterpret_cast<const bf16x8*>(P + (t0 + row) * LDP + PC_U + 2 * gp * 128 + part * 8); }
#pragma unroll
    for (int j = 0; j < 2; ++j)
#pragma unroll
      for (int ks = 0; ks < 4; ++ks) {
        if (64 * j + 16 * ks > 32 * w4 + 31) { pa[j][ks] = bf16x8{}; continue; }
        const u32x4 w = WPA[(size_t)((((g * 4 + w4) * 2 + j) * 4 + ks) * 64 + lane)]; pa[j][ks] = *reinterpret_cast<const bf16x8*>(&w); }
#pragma unroll
    for (int grp = 0; grp < 2; ++grp) { ggv[grp][0] = *(const f32x4*)(GGM + (2 * gp + grp) * 128 + sc); ggv[grp][1] = *(const f32x4*)(GGM + (2 * gp + grp) * 128 + sc + 4); }
    bias = BSP[g * 128 + t];
    __syncthreads();
#pragma unroll
    for (int grp = 0; grp < 2; ++grp)
#pragma unroll
      for (int rr = 0; rr < 4; ++rr) { const int s = rr * 32 + sr; *(bf16x8*)(lds + (grp * 2 + (s >> 6)) * SHM_V + v_st(s & 63, sc)) = scale8(vg[grp][rr], rv[s], ggv[grp][0], ggv[grp][1]); }
#pragma unroll
    for (int i = 0; i < 8; ++i) { const int c = tid + 512 * i, row = c >> 5, part = c & 31; *(bf16x8*)(ut + row * 512 + ((part ^ (row & 31)) << 4)) = uu[i]; } }
  __syncthreads();
  f32x16 o[4] = {};
  { const int vb = vb0 + (gsel * 2) * SHM_V;
    pv_one_t<0>(o[0], vb, pa[0][0], pa[0][1], pa[0][2], pa[0][3]); pv_one_t<1>(o[1], vb, pa[0][0], pa[0][1], pa[0][2], pa[0][3]);
    pv_one_t<2>(o[2], vb, pa[0][0], pa[0][1], pa[0][2], pa[0][3]); pv_one_t<3>(o[3], vb, pa[0][0], pa[0][1], pa[0][2], pa[0][3]); }
  if (w4 >= 2) { const int vb = vb0 + (gsel * 2 + 1) * SHM_V;
    pv_one_t<0>(o[0], vb, pa[1][0], pa[1][1], pa[1][2], pa[1][3]); pv_one_t<1>(o[1], vb, pa[1][0], pa[1][1], pa[1][2], pa[1][3]);
    pv_one_t<2>(o[2], vb, pa[1][0], pa[1][1], pa[1][2], pa[1][3]); pv_one_t<3>(o[3], vb, pa[1][0], pa[1][1], pa[1][2], pa[1][3]); }
  { char* urow = ut + t * 512 + 8 * hi;
#pragma unroll
    for (int d0 = 0; d0 < 4; ++d0)
#pragma unroll
      for (int q = 0; q < 4; ++q) { unsigned long long* p = (unsigned long long*)(urow + (((gsel * 16 + d0 * 4 + q) ^ r32) << 4));
        const unsigned long long uv = *p; const unsigned ua = (unsigned)uv, ub = (unsigned)(uv >> 32);
        const float a0 = __uint_as_float(ua << 16) * (o[d0][4 * q] + bias), a1 = __uint_as_float(ua & 0xffff0000u) * (o[d0][4 * q + 1] + bias);
        const float a2 = __uint_as_float(ub << 16) * (o[d0][4 * q + 2] + bias), a3 = __uint_as_float(ub & 0xffff0000u) * (o[d0][4 * q + 3] + bias);
        *p = (unsigned long long)cvtpk(a0, a1) | ((unsigned long long)cvtpk(a2, a3) << 32); } }
  __syncthreads();
#pragma unroll
  for (int i = 0; i < 8; ++i) { const int c = tid + 512 * i, row = c >> 5, part = c & 31;
    *(bf16x8*)(OGM + (t0 + row) * 1024 + 2 * gp * 128 + part * 8) = *(const bf16x8*)(ut + row * 512 + ((part ^ (row & 31)) << 4)); }
}

constexpr float XSCALE = 0.088388347648318440f, THR = 8.f;
__device__ __forceinline__ void partialSM(f32x16& p0, f32x16& p1, float& m_reg, float& mn, float& alpha) {
  constexpr float Cc = XSCALE * 1.4426950408889634f;
  float pmax = p0[0];
#pragma unroll
  for (int r = 1; r < 16; ++r) pmax = fmaxf(pmax, p0[r]);
#pragma unroll
  for (int r = 0; r < 16; ++r) pmax = fmaxf(pmax, p1[r]);
  { auto rr = __builtin_amdgcn_permlane32_swap(__float_as_uint(pmax), __float_as_uint(pmax), false, false);
    pmax = fmaxf(__uint_as_float(rr[0]), __uint_as_float(rr[1])); }
  if (__builtin_expect(__all(pmax - m_reg <= THR / XSCALE), 1)) { mn = m_reg; alpha = 1.f; }
  else { mn = fmaxf(m_reg, pmax); alpha = __builtin_amdgcn_exp2f((m_reg - mn) * Cc); m_reg = mn; }
  float mnC = -mn * Cc;
#pragma unroll
  for (int r = 0; r < 16; ++r) p0[r] = fmaf(p0[r], Cc, mnC);
#pragma unroll
  for (int r = 0; r < 16; ++r) p1[r] = fmaf(p1[r], Cc, mnC);
#pragma unroll
  for (int r = 0; r < 16; ++r) p0[r] = __builtin_amdgcn_exp2f(p0[r]);
}
__device__ __forceinline__ void finishSM(f32x16& p0, f32x16& p1, float alpha, float& l_reg, bf16x8& pa0, bf16x8& pa1, bf16x8& pa2, bf16x8& pa3) {
#pragma unroll
  for (int r = 0; r < 16; ++r) p1[r] = __builtin_amdgcn_exp2f(p1[r]);
  float ps = 0;
#pragma unroll
  for (int r = 0; r < 16; ++r) ps += p0[r];
#pragma unroll
  for (int r = 0; r < 16; ++r) ps += p1[r];
  { auto rr = __builtin_amdgcn_permlane32_swap(__float_as_uint(ps), __float_as_uint(ps), false, false);
    ps = __uint_as_float(rr[0]) + __uint_as_float(rr[1]); }
  l_reg = l_reg * alpha + ps;
  PK4(p0, 0, pa0); PK4(p0, 8, pa1); PK4(p1, 0, pa2); PK4(p1, 8, pa3);
}
template <int LDQ, int LDK, int LDO>
__device__ __forceinline__ void xattn_unit(const bf16_t* __restrict__ Qb, const bf16_t* __restrict__ Kh, const bf16_t* __restrict__ Vh, bf16_t* __restrict__ Ob, int seq, char* lds, lds_u16* stg) {
  int tid_ = threadIdx.x; asm volatile("" : "+v"(tid_));
  const int tid = tid_, wid = __builtin_amdgcn_readfirstlane(tid >> 6), lane = tid & 63, r32 = lane & 31, hi = lane >> 5;
  bf16_t* V_lds = (bf16_t*)lds; bf16_t* K_lds = (bf16_t*)(lds + SHM_V);
  float* ws = (float*)(lds + SHM_V + SHM_K) + wid * 64; float* li_l = ws; float* al_l = ws + 32;
  float m_reg = -1e30f, l_reg = 0; f32x16 o[4] = {}; bf16x8 qr[8];
  const bf16_t* Qw = Qb + (size_t)(wid * 32 + r32) * LDQ + hi * 8;
#pragma unroll
  for (int d0 = 0; d0 < 8; ++d0) qr[d0] = *reinterpret_cast<const bf16x8*>(Qw + d0 * 16);
  const int sr = tid >> 4, sc = (tid & 15) * 8, vst0 = v_st(sr, sc), vst1 = v_st(32 + sr, sc);
  const int vb0 = (int)(uintptr_t)V_lds + v_rd_base(lane);
  bf16x8 vs0, vs1, ks0, ks1;
#define SLOAD(k0) do { vs0 = *reinterpret_cast<const bf16x8*>(&Vh[(size_t)((k0) + sr) * LDK + sc]); vs1 = *reinterpret_cast<const bf16x8*>(&Vh[(size_t)((k0) + 32 + sr) * LDK + sc]); \
    ks0 = *reinterpret_cast<const bf16x8*>(&Kh[(size_t)((k0) + sr) * LDK + sc]); ks1 = *reinterpret_cast<const bf16x8*>(&Kh[(size_t)((k0) + 32 + sr) * LDK + sc]); } while (0)
#define SWRITE() do { *(bf16x8*)((char*)V_lds + vst0) = vs0; *(bf16x8*)((char*)V_lds + vst1) = vs1; \
    *(bf16x8*)((char*)K_lds + KSWZ(sr, sc * 2)) = ks0; *(bf16x8*)((char*)K_lds + KSWZ(32 + sr, sc * 2)) = ks1; } while (0)
  const int NT = seq / 64;
  SLOAD(0);
  for (int j = 0; j < NT; ++j) {
    asm volatile("s_waitcnt vmcnt(0)" ::: "memory");
    __syncthreads();
    SWRITE();
    if (j + 1 < NT) SLOAD((j + 1) * 64);
    __syncthreads();
    f32x16 p0, p1; float mn, alpha; bf16x8 pa0, pa1, pa2, pa3;
    qkt(p0, p1, K_lds, qr, r32, hi);
    partialSM(p0, p1, m_reg, mn, alpha);
    if (__any(alpha < 1.f)) { if (hi == 0) al_l[r32] = alpha; asm volatile("s_waitcnt lgkmcnt(0)" ::: "memory");
#pragma unroll
      for (int d = 0; d < 4; ++d)
#pragma unroll
        for (int r = 0; r < 16; ++r) o[d][r] *= al_l[crow(r, hi)]; }
    finishSM(p0, p1, alpha, l_reg, pa0, pa1, pa2, pa3);
    pv_d0(o, vb0, pa0, pa1, pa2, pa3);
  }
  if (hi == 0) li_l[r32] = l_reg; asm volatile("s_waitcnt lgkmcnt(0)" ::: "memory");
  float rli[16];
#pragma unroll
  for (int r = 0; r < 16; ++r) rli[r] = __builtin_amdgcn_rcpf(li_l[crow(r, hi)]);
  store_o_bf16(o, rli, Ob + (size_t)(wid * 32) * LDO, LDO, lane, stg + wid * 1024);
#undef SLOAD
#undef SWRITE
}
#undef PK4
#undef KSWZ
#undef SBAR
}

constexpr int NWAVES = 8;
#ifndef PHASE_MASK
#define PHASE_MASK 0xFFFF
#endif
#ifndef REP_MASK
#define REP_MASK 0x0
#endif
#if REP_MASK == 0
#define PH(k) if constexpr ((PHASE_MASK >> (k)) & 1)
#else
#define PH(k) for (int rep_ = 0; rep_ < ((((PHASE_MASK) >> (k)) & 1) ? ((((REP_MASK) >> (k)) & 1) ? 2 : 1) : 0); ++rep_)
#endif
constexpr size_t MiB = 1u << 20;
constexpr size_t WS_CTL = 0, CTL_ZERO_BYTES = 128 * 1024;
constexpr size_t WS_SSV = 1 * MiB;
constexpr size_t WS_SS1 = 3 * MiB;
constexpr size_t WS_WPA = 7 * MiB + 768 * 1024;
constexpr size_t WS_XINV = 7 * MiB + 512 * 1024;
constexpr size_t WS_MG = 224 * MiB;
constexpr size_t WS_WRH = 7 * MiB, WS_WRL = 7 * MiB + 256 * 1024;
constexpr size_t WS_TOKL = 8 * MiB, WS_SLOTL = 12 * MiB, WS_WL = 16 * MiB, WS_RSL = 20 * MiB;
constexpr size_t WS_MEMN = 24 * MiB;
constexpr size_t WS_MKV = 26 * MiB;
constexpr size_t WS_WIN = 32 * MiB, WS_WSB = 68 * MiB, WS_WGM = 72 * MiB, WS_WOUT = 76 * MiB, WS_WXQ = 84 * MiB, WS_WXKV = 86 * MiB, WS_WXO = 90 * MiB;
constexpr size_t WS_W1 = 96 * MiB;
constexpr size_t WS_W2 = 352 * MiB;
constexpr size_t WS_PROJ = 480 * MiB;
constexpr size_t WS_X1F = 480 * MiB;
constexpr size_t WS_X1B = 736 * MiB;
constexpr size_t WS_QX = 864 * MiB;
constexpr size_t WS_OX = 896 * MiB;
constexpr size_t WS_X2B = 928 * MiB;
constexpr size_t WS_X28 = 552 * MiB;
constexpr size_t WS_H = 480 * MiB;
constexpr size_t WS_Y = 624 * MiB;
constexpr size_t WS_END = 1056 * MiB;
constexpr size_t DO_XB = 0, DO_OSB = 128 * MiB, DO_OGM = 192 * MiB, DO_MG = 0;
constexpr int CW_BAR = 4096;
constexpr int CW_CNT = 16384;
constexpr int RING_BYTES = 131072, LDSCTL_OFF = RING_BYTES, MISC_OFF = LDSCTL_OFF + 320, TB_OFF = LDSCTL_OFF + 512, HIST_OFF = LDSCTL_OFF + 768, BASE_OFF = LDSCTL_OFF + 1024, SBFLAG_OFF = LDSCTL_OFF + 1280, STG_OFF = LDSCTL_OFF + 2048;
constexpr int LDS_BYTES = 151552;

#define GAS __attribute__((address_space(1)))
#define LAS __attribute__((address_space(3)))
typedef unsigned short bf16;
typedef unsigned v4u __attribute__((ext_vector_type(4)));
typedef float f32x4 __attribute__((ext_vector_type(4)));
typedef short bf16x8 __attribute__((ext_vector_type(8)));
typedef GAS unsigned gu32;
#define RLX_AGENT __ATOMIC_RELAXED, __HIP_MEMORY_SCOPE_AGENT
#define LDS_WAIT() asm volatile("s_waitcnt lgkmcnt(0)" ::: "memory")
#define VM_WAIT() asm volatile("s_waitcnt vmcnt(0)" ::: "memory")
__device__ __forceinline__ unsigned f2bf(float f) { unsigned u = __builtin_bit_cast(unsigned, f); return (u + 0x7fffu + ((u >> 16) & 1u)) >> 16; }
__device__ __forceinline__ unsigned pk2(float lo, float hi) { return f2bf(lo) | (f2bf(hi) << 16); }

#define XB_TMO      128
#define XB_XCNT(j)  (256  + 64 * (j))
#define XB_XSUB(j)  (1280 + 64 * (j))
#define XB_XGEN(j)  (2304 + 64 * (j))
#define XB_TOP      3328
#define XB_TOPGEN   3392
#define XCD_BAR_WORDS 3456
#define XB_SPIN_CAP (1u << 18)
__device__ __forceinline__ unsigned xb_ld(unsigned* p)              { return __hip_atomic_load(p, __ATOMIC_RELAXED, __HIP_MEMORY_SCOPE_AGENT); }
__device__ __forceinline__ unsigned xb_add(unsigned* p, unsigned v) { return __hip_atomic_fetch_add(p, v, __ATOMIC_RELAXED, __HIP_MEMORY_SCOPE_AGENT); }
__device__ __forceinline__ unsigned xb_xcc_id() { return (unsigned)__builtin_amdgcn_s_getreg((3 << 11) | 20) & 0xFu; }
#define XB_SPIN(cond, bar) do { unsigned _sp = 0; while (cond) { __builtin_amdgcn_s_sleep(1); \
    if ((++_sp & 255u) == 0u) { if (xb_ld(&(bar)[XB_TMO])) break; if (_sp > XB_SPIN_CAP) { atomicAdd(&(bar)[XB_TMO], 1u); break; } } } } while (0)
struct XcdBarrier { unsigned* bar; unsigned x; volatile LAS unsigned* st; };
__device__ __forceinline__ XcdBarrier xcd_barrier_post(unsigned* bar, volatile LAS unsigned* st) {
    XcdBarrier b; b.bar = bar; b.x = xb_xcc_id(); b.st = st;
    if (threadIdx.x == 0) (void)xb_add(&bar[XB_XCNT(b.x)], 1u);
    return b;
}
__device__ __forceinline__ void xcd_barrier_complete(unsigned* bar, unsigned x, unsigned& nloc, unsigned& nx) {
    const unsigned G = gridDim.x * gridDim.y * gridDim.z;
    unsigned sum, cnt, mine, sp = 0u;
    for (;;) {
        sum = 0u; cnt = 0u; mine = 0u;
#pragma unroll
        for (unsigned j = 0; j < 16; ++j) { const unsigned c = xb_ld(&bar[XB_XCNT(j)]); sum += c; cnt += (c > 0u) ? 1u : 0u; mine = (j == x) ? c : mine; }
        if (sum == G) break;
        __builtin_amdgcn_s_sleep(1);
        if ((++sp & 255u) == 0u) { if (xb_ld(&bar[XB_TMO])) break; if (sp > XB_SPIN_CAP) { atomicAdd(&bar[XB_TMO], 1u); break; } }
    }
    nloc = mine > 0u ? mine : 1u; nx = cnt > 0u ? cnt : 1u;
}
__device__ __forceinline__ void xcd_barrier(const XcdBarrier& b) {
    asm volatile("s_waitcnt vmcnt(0)" ::: "memory");
    __syncthreads();
    if (threadIdx.x == 0) {
        unsigned* bar = b.bar;
        __builtin_amdgcn_s_waitcnt(0);
        unsigned nloc = b.st[0], nx = b.st[1];
        if (nloc == 0u) { xcd_barrier_complete(bar, b.x, nloc, nx); b.st[0] = nloc; b.st[1] = nx; }
        const unsigned old = xb_add(&bar[XB_XSUB(b.x)], 1u);
        const unsigned gen = old / nloc;
        if (old + 1u == (gen + 1u) * nloc) {
            __builtin_amdgcn_fence(__ATOMIC_RELEASE, "agent");
            asm volatile("s_waitcnt vmcnt(0)" ::: "memory");
            const unsigned og = xb_add(&bar[XB_TOP], 1u);
            const unsigned tg = og / nx;
            if (og + 1u == (tg + 1u) * nx) xb_add(&bar[XB_TOPGEN], 1u);
            else XB_SPIN(xb_ld(&bar[XB_TOPGEN]) == tg, bar);
            __builtin_amdgcn_fence(__ATOMIC_ACQUIRE, "agent");
            xb_add(&bar[XB_XGEN(b.x)], 1u);
            asm volatile("s_waitcnt vmcnt(0)" ::: "memory");
        } else {
            XB_SPIN(xb_ld(&bar[XB_XGEN(b.x)]) == gen, bar);
            __builtin_amdgcn_fence(__ATOMIC_ACQUIRE, "agent");
            asm volatile("s_waitcnt vmcnt(0)" ::: "memory");
        }
    }
    __syncthreads();
}

__device__ __forceinline__ float wave_sum(float v) {
#pragma unroll
    for (int o = 1; o < 64; o <<= 1) v += __shfl_xor(v, o);
    return v;
}
__device__ __forceinline__ void transpose_item(const float* W, int K, int N, bf16* WT, int k0, int n0, int drow0, const float* gk, LAS float* scr, int lane, float cs = 1.0f) {
    { f32x4 ld[8];
#pragma unroll
      for (int i = 0; i < 8; ++i) ld[i] = *(const GAS f32x4*)(W + (size_t)(k0 + 8 * i + (lane >> 3)) * N + n0 + 4 * (lane & 7));
#pragma unroll
      for (int i = 0; i < 8; ++i) { LAS float* p = scr + (8 * i + (lane >> 3)) * 33 + 4 * (lane & 7); p[0] = ld[i].x; p[1] = ld[i].y; p[2] = ld[i].z; p[3] = ld[i].w; } }
    LDS_WAIT(); asm volatile("" ::: "memory");
    const int c = lane & 7;
    float gs[8];
#pragma unroll
    for (int q = 0; q < 8; ++q) gs[q] = (gk ? gk[k0 + 8 * c + q] : 1.0f) * cs;
#pragma unroll
    for (int j = 0; j < 4; ++j) { const int n = (lane >> 3) + 8 * j; const LAS float* s = scr + (8 * c) * 33 + n;
        v4u o; o.x = pk2(s[0 * 33] * gs[0], s[1 * 33] * gs[1]); o.y = pk2(s[2 * 33] * gs[2], s[3 * 33] * gs[3]); o.z = pk2(s[4 * 33] * gs[4], s[5 * 33] * gs[5]); o.w = pk2(s[6 * 33] * gs[6], s[7 * 33] * gs[7]);
        *(GAS v4u*)(WT + (size_t)(drow0 + n) * K + k0 + 8 * c) = o; }
    LDS_WAIT(); asm volatile("" ::: "memory");
}
__device__ __forceinline__ void transpose_item_bf8(const float* W, int K, int N, unsigned char* WT, int k0, int n0, int drow0, const float* gk, LAS float* scr, int lane) {
    { f32x4 ld[8];
#pragma unroll
      for (int i = 0; i < 8; ++i) ld[i] = *(const GAS f32x4*)(W + (size_t)(k0 + 8 * i + (lane >> 3)) * N + n0 + 4 * (lane & 7));
#pragma unroll
      for (int i = 0; i < 8; ++i) { LAS float* p = scr + (8 * i + (lane >> 3)) * 33 + 4 * (lane & 7); p[0] = ld[i].x; p[1] = ld[i].y; p[2] = ld[i].z; p[3] = ld[i].w; } }
    LDS_WAIT(); asm volatile("" ::: "memory");
    const int c = lane & 7;
    float gs[8];
#pragma unroll
    for (int q = 0; q < 8; ++q) gs[q] = gk ? gk[k0 + 8 * c + q] : 1.0f;
#pragma unroll
    for (int j = 0; j < 4; ++j) { const int n = (lane >> 3) + 8 * j; const LAS float* s = scr + (8 * c) * 33 + n;
        int lo = __builtin_amdgcn_cvt_pk_bf8_f32(s[0 * 33] * gs[0], s[1 * 33] * gs[1], 0, false); lo = __builtin_amdgcn_cvt_pk_bf8_f32(s[2 * 33] * gs[2], s[3 * 33] * gs[3], lo, true);
        int hi = __builtin_amdgcn_cvt_pk_bf8_f32(s[4 * 33] * gs[4], s[5 * 33] * gs[5], 0, false); hi = __builtin_amdgcn_cvt_pk_bf8_f32(s[6 * 33] * gs[6], s[7 * 33] * gs[7], hi, true);
        *(GAS unsigned long long*)(WT + (size_t)(drow0 + n) * K + k0 + 8 * c) = (unsigned long long)(unsigned)lo | ((unsigned long long)(unsigned)hi << 32); }
    LDS_WAIT(); asm volatile("" ::: "memory");
}
__device__ __forceinline__ void transpose_item_fp8(const float* W, int K, int N, unsigned char* WT, int k0, int n0, int drow0, const float* gk, LAS float* scr, int lane, float cs) {
    { f32x4 ld[8];
#pragma unroll
      for (int i = 0; i < 8; ++i) ld[i] = *(const GAS f32x4*)(W + (size_t)(k0 + 8 * i + (lane >> 3)) * N + n0 + 4 * (lane & 7));
#pragma unroll
      for (int i = 0; i < 8; ++i) { LAS float* p = scr + (8 * i + (lane >> 3)) * 33 + 4 * (lane & 7); p[0] = ld[i].x; p[1] = ld[i].y; p[2] = ld[i].z; p[3] = ld[i].w; } }
    LDS_WAIT(); asm volatile("" ::: "memory");
    const int c = lane & 7;
    float gs[8];
#pragma unroll
    for (int q = 0; q < 8; ++q) gs[q] = (gk ? gk[k0 + 8 * c + q] : 1.0f) * cs;
#pragma unroll
    for (int j = 0; j < 4; ++j) { const int n = (lane >> 3) + 8 * j; const LAS float* s = scr + (8 * c) * 33 + n;
        int lo = __builtin_amdgcn_cvt_pk_fp8_f32(s[0 * 33] * gs[0], s[1 * 33] * gs[1], 0, false); lo = __builtin_amdgcn_cvt_pk_fp8_f32(s[2 * 33] * gs[2], s[3 * 33] * gs[3], lo, true);
        int hi = __builtin_amdgcn_cvt_pk_fp8_f32(s[4 * 33] * gs[4], s[5 * 33] * gs[5], 0, false); hi = __builtin_amdgcn_cvt_pk_fp8_f32(s[6 * 33] * gs[6], s[7 * 33] * gs[7], hi, true);
        *(GAS unsigned long long*)(WT + (size_t)(drow0 + n) * K + k0 + 8 * c) = (unsigned long long)(unsigned)lo | ((unsigned long long)(unsigned)hi << 32); }
    LDS_WAIT(); asm volatile("" ::: "memory");
}
__device__ __forceinline__ void rms_row_to_bf16(const float* xrow, bf16* orow, int lane, float* inv_out = nullptr, unsigned char* o8row = nullptr) {
    const GAS f32x4* xr = (const GAS f32x4*)xrow + lane;
    f32x4 v[8]; float s = 0.f;
#pragma unroll
    for (int j = 0; j < 8; ++j) { v[j] = xr[64 * j]; s += (v[j].x * v[j].x + v[j].y * v[j].y) + (v[j].z * v[j].z + v[j].w * v[j].w); }
    const float ms = wave_sum(s) * (1.f / DM) + EPS; const float rstd = __builtin_amdgcn_rsqf(ms);
    if (inv_out && lane == 0) *inv_out = __builtin_sqrtf(ms);
    GAS unsigned long long* o8 = (GAS unsigned long long*)orow + lane;
#pragma unroll
    for (int j = 0; j < 8; ++j) o8[64 * j] = (unsigned long long)pk2(v[j].x * rstd, v[j].y * rstd) | ((unsigned long long)pk2(v[j].z * rstd, v[j].w * rstd) << 32);
    if (o8row) {
#pragma unroll
        for (int j = 0; j < 8; ++j) ((GAS unsigned*)o8row)[lane + 64 * j] = pg8::pk_fp8x4(v[j].x * rstd, v[j].y * rstd, v[j].z * rstd, v[j].w * rstd); }
}

struct Args { const float* in[24]; float* out; unsigned char* ws; };

__global__ void __launch_bounds__(NWAVES * 64, 2) fwd_kernel(Args args) {
    extern __shared__ __attribute__((aligned(16))) unsigned char lds[];
    LAS unsigned char* L = (LAS unsigned char*)lds;
    volatile LAS unsigned* MISC = (volatile LAS unsigned*)(L + MISC_OFF);
    const int tid = threadIdx.x, lane = tid & 63, wave = __builtin_amdgcn_readfirstlane(tid >> 6);
    const int G = gridDim.x; const int bx = blockIdx.x; const int vcu = (G % 8 == 0) ? (bx % 8) * (G / 8) + bx / 8 : bx;
    gu32* ctl = (gu32*)(args.ws + WS_CTL);
#define INP(k) (args.in[k])
#define p_x (INP(0))
#define p_mem (INP(1))
#define p_g_mix (INP(2))
#define p_w_in (INP(3))
#define p_g_gm (INP(4))
#define p_w_spatial (INP(5))
#define p_b_spatial (INP(6))
#define p_w_bsb (INP(7))
#define p_w_bgm (INP(8))
#define p_w_out (INP(9))
#define p_g_cross (INP(10))
#define p_g_mem (INP(11))
#define p_w_xq (INP(12))
#define p_w_xkv (INP(13))
#define p_w_xo (INP(14))
#define p_g_ffn (INP(15))
#define p_w_rg (INP(16))
#define p_b_rg (INP(17))
#define p_w_re (INP(18))
#define p_b_re (INP(19))
#define p_w_eg (INP(20))
#define p_w_eu (INP(21))
#define p_w_ed (INP(22))
#define p_g_final (INP(23))
#define WSPTR(ty, off) ((ty*)(args.ws + (off)))
#define DOPTR(ty, off) ((ty*)((unsigned char*)args.out + (off)))
#define SSV WSPTR(float, WS_SSV)
#define SS1 WSPTR(float, WS_SS1)
#define WRH WSPTR(bf16, WS_WRH)
#define WRL WSPTR(bf16, WS_WRL)
#define TOKL WSPTR(int, WS_TOKL)
#define SLOTL WSPTR(int, WS_SLOTL)
#define WL WSPTR(float, WS_WL)
#define RSL WSPTR(float, WS_RSL)
#define MEMN WSPTR(bf16, WS_MEMN)
#define MKV WSPTR(bf16, WS_MKV)
#define WIN WSPTR(bf16, WS_WIN)
#define WSB WSPTR(bf16, WS_WSB)
#define WGM WSPTR(bf16, WS_WGM)
#define WOUT WSPTR(bf16, WS_WOUT)
#define WXQ WSPTR(bf16, WS_WXQ)
#define WXKV WSPTR(bf16, WS_WXKV)
#define WXO WSPTR(bf16, WS_WXO)
#define W1 WSPTR(bf16, WS_W1)
#define W2 WSPTR(bf16, WS_W2)
#define PROJ WSPTR(bf16, WS_PROJ)
#define X1F WSPTR(float, WS_X1F)
#define X1B WSPTR(bf16, WS_X1B)
#define QX WSPTR(bf16, WS_QX)
#define OX WSPTR(bf16, WS_OX)
#define X2B WSPTR(bf16, WS_X2B)
#define X28 WSPTR(bf16, WS_X28)
#define HB WSPTR(bf16, WS_H)
#define YB WSPTR(bf16, WS_Y)
#define XB DOPTR(bf16, DO_XB)
#define XB8 DOPTR(unsigned char, DO_OSB)
#define WG8 (WSPTR(unsigned char, WS_WIN) + (size_t)PC_GS * DM * 2)
#define OSB DOPTR(bf16, DO_OSB)
#define OGM DOPTR(bf16, DO_OGM)
#define MG WSPTR(bf16, WS_MG)
#define XINV WSPTR(float, WS_XINV)
#define X2F (args.out)

    for (int u = tid; u < (LDS_BYTES - LDSCTL_OFF) / 4; u += NWAVES * 64) ((LAS unsigned*)(L + LDSCTL_OFF))[u] = 0u;
    __syncthreads();
    XcdBarrier bar = xcd_barrier_post((unsigned*)(ctl + CW_BAR), MISC + 8);
    const int gw = vcu * NWAVES + wave, NGW = G * NWAVES;

    PH(0) {
    {
        LAS float* scr = (LAS float*)(L + wave * 16384);
        constexpr int I_IN = 32 * 288, I_SB = 16 * 64, I_GM = 16 * 64, I_OUT = 32 * 64, I_XQ = 32 * 16, I_XKV = 32 * 32, I_XO = 8 * 64, I_EG = 32 * 32, I_ED = 16 * 64;
        constexpr int NSMALL = I_IN + I_SB + I_GM + I_OUT + I_XQ + I_XKV + I_XO;
        constexpr int NITEMS = NSMALL + NEXP * (2 * I_EG + I_ED);
        for (int it = gw; it < NITEMS; it += NGW) {
            int r = it;
            if (r < I_IN) { const int nb = 288, n0 = 32 * (r % nb);
                if (n0 < PC_GS) transpose_item(p_w_in, 2048, 9216, WIN, 64 * (r / nb), n0, n0, p_g_mix, scr, lane);
                else transpose_item_fp8(p_w_in, 2048, 9216, WG8, 64 * (r / nb), n0, n0 - PC_GS, p_g_mix, scr, lane, -1.4426950408889634f * 16.0f);
                continue; } r -= I_IN;
            if (r < I_SB) { const int nb = 64; transpose_item(p_w_bsb, 1024, 2048, WSB, 64 * (r / nb), 32 * (r % nb), 32 * (r % nb), nullptr, scr, lane); continue; } r -= I_SB;
            if (r < I_GM) { const int nb = 64; transpose_item(p_w_bgm, 1024, 2048, WGM, 64 * (r / nb), 32 * (r % nb), 32 * (r % nb), nullptr, scr, lane); continue; } r -= I_GM;
            if (r < I_OUT) { const int nb = 64; transpose_item(p_w_out, 2048, 2048, WOUT, 64 * (r / nb), 32 * (r % nb), 32 * (r % nb), nullptr, scr, lane); continue; } r -= I_OUT;
            if (r < I_XQ) { const int nb = 16; transpose_item(p_w_xq, 2048, 512, WXQ, 64 * (r / nb), 32 * (r % nb), 32 * (r % nb), p_g_cross, scr, lane); continue; } r -= I_XQ;
            if (r < I_XKV) { const int nb = 32; transpose_item(p_w_xkv, 2048, 1024, WXKV, 64 * (r / nb), 32 * (r % nb), 32 * (r % nb), p_g_mem, scr, lane); continue; } r -= I_XKV;
            if (r < I_XO) { const int nb = 64; transpose_item(p_w_xo, 512, 2048, WXO, 64 * (r / nb), 32 * (r % nb), 32 * (r % nb), nullptr, scr, lane); continue; } r -= I_XO;
            const int e = r / (2 * I_EG + I_ED); r -= e * (2 * I_EG + I_ED);
            if (r < 2 * I_EG) { const int up = r >= I_EG ? 1 : 0; r -= up * I_EG; const int nb = 32, n0 = 32 * (r % nb);
                transpose_item_fp8((up ? p_w_eu : p_w_eg) + (size_t)e * 2048 * 1024, 2048, 1024, (unsigned char*)W1 + (size_t)e * 2048 * 2048, 64 * (r / nb), n0, (n0 >> 7) * 256 + up * 128 + (n0 & 127), p_g_ffn, scr, lane, 64.0f); continue; }
            r -= 2 * I_EG;
            { const int nb = 64; transpose_item_fp8(p_w_ed + (size_t)e * 1024 * 2048, 1024, 2048, (unsigned char*)W2 + (size_t)e * 2048 * 1024, 64 * (r / nb), 32 * (r % nb), 32 * (r % nb), nullptr, scr, lane, 64.0f); }
        }
        for (int m = gw; m < T; m += NGW) rms_row_to_bf16(p_x + (size_t)m * DM, XB + (size_t)m * DM, lane, XINV + m, XB8 + (size_t)m * DM);
        for (int m = gw; m < BATCH * NMEM; m += NGW) rms_row_to_bf16(p_mem + (size_t)m * DM, MEMN + (size_t)m * DM, lane);
        for (int i = bx * 512 + tid; i < NEXP * CAP; i += G * 512) { TOKL[i] = 0; SLOTL[i] = -1; }
        for (int i = bx * 512 + tid; i < 48 * 2048; i += G * 512) { const int e = i >> 11, k = i & 2047;
            float w = 0.f; if (e < 32) w = p_w_re[(size_t)k * 32 + e] * p_g_ffn[k]; else if (e < 36) w = p_w_rg[(size_t)k * 4 + (e - 32)] * p_g_ffn[k];
            const unsigned hb = f2bf(w); const float hf = __uint_as_float(hb << 16); WRH[i] = (bf16)hb; WRL[i] = (bf16)f2bf(w - hf); }
        for (int i = bx * 512 + tid; i < 8 * 4 * 2 * 4 * 64; i += G * 512) { const int ln = i & 63, ks = (i >> 6) & 3, j = (i >> 8) & 1, w4 = (i >> 9) & 3, g = i >> 11;
            const int t = 32 * w4 + (ln & 31), s0 = 64 * j + 16 * ks + 8 * (ln >> 5); const float* wr_ = p_w_spatial + ((size_t)g * 128 + t) * 128 + s0;
            float v[8];
#pragma unroll
            for (int k = 0; k < 8; ++k) v[k] = (s0 + k <= t) ? wr_[k] : 0.f;
            att::u32x4 o; o.x = att::cvtpk(v[0], v[1]); o.y = att::cvtpk(v[2], v[3]); o.z = att::cvtpk(v[4], v[5]); o.w = att::cvtpk(v[6], v[7]);
            WSPTR(att::u32x4, WS_WPA)[i] = o; }
    }
    }
    xcd_barrier(bar);

    PH(1) {
    {
        pg8::Gemm g{XB, WIN, T, PC_GS, DM}; pg8::StaticOrder S; S.init(T, PC_GS, G, bx, 4);
        pg8::EpiIn E{PROJ, SSV};
        pg8::gemm_phase<pg8::EpiIn, pg8::StaticOrder, false>(L, g, S, E);
    }
    {
        pg8::Gemm g{(const pg8::bf16_t*)XB8, (const pg8::bf16_t*)WG8, T, LDP - PC_GS, DM / 2}; pg8::StaticOrder S; S.init(T, LDP - PC_GS, G, bx);
        pg8::EpiGateQ E{PROJ};
        pg8::gemm_phase<pg8::EpiGateQ, pg8::StaticOrder, false, true, 0, 0x7B7B7B7Bu>(L, g, S, E);
    }
    {
        typedef short bf16x8_ __attribute__((ext_vector_type(8))); typedef float f4_ __attribute__((ext_vector_type(4)));
        int tk_ = threadIdx.x; asm volatile("" : "+v"(tk_));
        const int ln_ = tk_ & 63, r_ = ln_ & 15, kq_ = ln_ >> 4;
        for (int t = vcu; t < 256; t += G) {
            const int row0 = (t >> 4) * 32 + (wave >> 2) * 16, col0 = (t & 15) * 64 + (wave & 3) * 16;
            const bf16* ap = MEMN + (size_t)(row0 + r_) * DM + 8 * kq_; const bf16* bp = WXKV + (size_t)(col0 + r_) * DM + 8 * kq_;
            f4_ acc[4] = {{0.f, 0.f, 0.f, 0.f}, {0.f, 0.f, 0.f, 0.f}, {0.f, 0.f, 0.f, 0.f}, {0.f, 0.f, 0.f, 0.f}};
#pragma unroll 2
            for (int ks = 0; ks < 64; ks += 4) {
                bf16x8_ a[4], b[4];
#pragma unroll
                for (int j = 0; j < 4; ++j) { a[j] = *(const bf16x8_*)(ap + 32 * (ks + j)); b[j] = *(const bf16x8_*)(bp + 32 * (ks + j)); }
#pragma unroll
                for (int j = 0; j < 4; ++j) acc[j] = __builtin_amdgcn_mfma_f32_16x16x32_bf16(b[j], a[j], acc[j], 0, 0, 0);
            }
            const f4_ s = (acc[0] + acc[1]) + (acc[2] + acc[3]);
            *(unsigned long long*)(MKV + (size_t)(row0 + r_) * 1024 + col0 + 4 * kq_) = (unsigned long long)pk2(s[0], s[1]) | ((unsigned long long)pk2(s[2], s[3]) << 32);
        }
    }
    }
    xcd_barrier(bar);

    PH(2) {
#pragma unroll 1
    for (int pass = 0; pass < 2; ++pass) {
        if ((pass ^ ((bx >> 3) & 1)) == 0) {
            for (int u = vcu; u < BATCH * 4 * 128; u += G) { const int qblk = u & 127, hp = (u >> 7) & 3, b = u >> 9;
                att::sb_unit(PROJ, OSB, b, hp, qblk, (char*)lds, L, (volatile LAS int*)(L + SBFLAG_OFF), (att::lds_u16*)(L + STG_OFF)); }
        } else {
            for (int u = vcu; u < 256 * 4; u += G) { const int gp = u & 3, chunk = u >> 2; att::gm_unit2(PROJ, SSV, WSPTR(att::u32x4, WS_WPA), p_b_spatial, p_g_gm, OGM, chunk, gp, (char*)lds, (float*)(lds + STG_OFF)); }
        }
        __syncthreads();
    }
    }
    xcd_barrier(bar);

    PH(3) {
    {
        pg8::Gemm g{OSB, WSB, T, DM, 1024}; pg8::PairOrder S; S.S.init(T, DM, G, bx); S.A1 = OGM; S.B1 = WGM;
        pg8::EpiGate3 E{PROJ, MG};
        pg8::gemm_phase<pg8::EpiGate3, pg8::PairOrder, false>(L, g, S, E);
    }
    }
    xcd_barrier(bar);

    PH(4) {
    {
        pg8::Gemm g{MG, WOUT, T, DM, DM}; pg8::StaticOrder S; S.init(T, DM, G, bx);
        pg8::EpiRes E{XB, XINV, X1B, SS1};
        pg8::gemm_phase<pg8::EpiRes, pg8::StaticOrder, false>(L, g, S, E);
    }
    }
    xcd_barrier(bar);

    PH(5) {
    pg8::StaticOrder S5; S5.init(T, 512, G, bx);
    {
        pg8::Gemm g{X1B, WXQ, T, 512, DM};
        pg8::EpiRowScale E{SS1, QX, 512};
        pg8::gemm_phase<pg8::EpiRowScale, pg8::StaticOrder, false>(L, g, S5, E);
    }
    asm volatile("s_waitcnt vmcnt(0)" ::: "memory"); __syncthreads();
    { pg8::Unit u;
      for (int i = 0; S5.next(i, u); ++i) { const int b = u.pm >> 6, qb = u.pm & 63;
#pragma unroll 1
        for (int hh = 0; hh < 2; ++hh) { const int h = 2 * u.pn + hh;
            att::xattn_unit<512, 1024, 512>(QX + ((size_t)b * SEQ + qb * 256) * 512 + h * 128, MKV + (size_t)b * NMEM * 1024 + h * 128, MKV + (size_t)b * NMEM * 1024 + 512 + h * 128,
                                           OX + ((size_t)b * SEQ + qb * 256) * 512 + h * 128, NMEM, (char*)lds, (att::lds_u16*)(L + STG_OFF)); } } }
    }
    xcd_barrier(bar);

    PH(7) {
    {
        pg8::Gemm g{OX, WXO, T, DM, 512}; pg8::StaticOrder S; S.init(T, DM, G, bx);
        pg8::EpiResB E{X1B, X2B, (unsigned char*)X28};
        pg8::gemm_phase<pg8::EpiResB, pg8::StaticOrder, false>(L, g, S, E);
    }
    }
    xcd_barrier(bar);

    PH(8) {
    int tid8_ = threadIdx.x; asm volatile("" : "+v"(tid8_)); const int tid = tid8_, lane = tid8_ & 63;
    {
        typedef float f4 __attribute__((ext_vector_type(4)));
        constexpr int RT_PITCH = 528, RT_HALF = 48 * RT_PITCH, RT_BUF = 2 * RT_HALF;
        LAS float* lg = (LAS float*)(L + 2 * RT_BUF + wave * 3072);
        LAS int* hist = (LAS int*)(L + HIST_OFF); LAS int* basee = (LAS int*)(L + BASE_OFF);
        const int n = lane & 15, kq = lane >> 4;
        for (int chunk = vcu; chunk < T / 128; chunk += G) {
            __syncthreads(); if (tid < 32) hist[tid] = 0; __syncthreads();
            const int tok0 = chunk * 128 + wave * 16;
            const bf16* xp = X2B + (size_t)(tok0 + n) * DM + 8 * kq;
            f4 acc0 = {0.f, 0.f, 0.f, 0.f}, acc1 = acc0, acc2 = acc0; float ss = 0.f;
            v4u wreg[6], xv[8], xn[8];
#define RT_WLOAD(sl) do { _Pragma("unroll") for (int i_ = 0; i_ < 6; ++i_) { const int c_ = tid + 512 * i_, wh_ = c_ / 1536, cc_ = c_ % 1536, row_ = cc_ >> 5, part_ = cc_ & 31; \
                wreg[i_] = *(const v4u*)((wh_ ? WRL : WRH) + (size_t)row_ * DM + (sl) * 256 + part_ * 8); } } while (0)
#define RT_WSTORE(bufb) do { _Pragma("unroll") for (int i_ = 0; i_ < 6; ++i_) { const int c_ = tid + 512 * i_, wh_ = c_ / 1536, cc_ = c_ % 1536, row_ = cc_ >> 5, part_ = cc_ & 31; \
                *(LAS v4u*)(L + (bufb) * RT_BUF + wh_ * RT_HALF + row_ * RT_PITCH + part_ * 16) = wreg[i_]; } } while (0)
            RT_WLOAD(0);
#pragma unroll
            for (int st = 0; st < 8; ++st) xv[st] = *(const v4u*)(xp + 32 * st);
#pragma unroll 1
            for (int sl = 0; sl < 8; ++sl) {
                RT_WSTORE(sl & 1);
                if (sl < 7) { RT_WLOAD(sl + 1);
#pragma unroll
                    for (int st = 0; st < 8; ++st) xn[st] = *(const v4u*)(xp + (sl + 1) * 256 + 32 * st); }
                __syncthreads();
                const LAS unsigned char* wb = L + (sl & 1) * RT_BUF + n * RT_PITCH + kq * 16;
#pragma unroll
                for (int st = 0; st < 8; ++st) {
                    const v4u xw = xv[st]; const bf16x8 xh = __builtin_bit_cast(bf16x8, xw);
#pragma unroll
                    for (int k = 0; k < 4; ++k) { const float lo = __uint_as_float(xw[k] << 16), hi_ = __uint_as_float(xw[k] & 0xffff0000u); ss += lo * lo + hi_ * hi_; }
                    { const bf16x8 wh = *(const LAS bf16x8*)(wb + st * 64), wl = *(const LAS bf16x8*)(wb + RT_HALF + st * 64);
                      acc0 = __builtin_amdgcn_mfma_f32_16x16x32_bf16(wh, xh, acc0, 0, 0, 0); acc0 = __builtin_amdgcn_mfma_f32_16x16x32_bf16(wl, xh, acc0, 0, 0, 0); }
                    { const bf16x8 wh = *(const LAS bf16x8*)(wb + 16 * RT_PITCH + st * 64), wl = *(const LAS bf16x8*)(wb + RT_HALF + 16 * RT_PITCH + st * 64);
                      acc1 = __builtin_amdgcn_mfma_f32_16x16x32_bf16(wh, xh, acc1, 0, 0, 0); acc1 = __builtin_amdgcn_mfma_f32_16x16x32_bf16(wl, xh, acc1, 0, 0, 0); }
                    { const bf16x8 wh = *(const LAS bf16x8*)(wb + 32 * RT_PITCH + st * 64), wl = *(const LAS bf16x8*)(wb + RT_HALF + 32 * RT_PITCH + st * 64);
                      acc2 = __builtin_amdgcn_mfma_f32_16x16x32_bf16(wh, xh, acc2, 0, 0, 0); acc2 = __builtin_amdgcn_mfma_f32_16x16x32_bf16(wl, xh, acc2, 0, 0, 0); }
                }
                if (sl < 7) {
#pragma unroll
                    for (int st = 0; st < 8; ++st) xv[st] = xn[st]; }
            }
#undef RT_WLOAD
#undef RT_WSTORE
            ss += __shfl_xor(ss, 16); ss += __shfl_xor(ss, 32);
            const float rstd = __builtin_amdgcn_rsqf(ss * (1.f / DM) + EPS);
#pragma unroll
            for (int r = 0; r < 4; ++r) { lg[n * 48 + 4 * kq + r] = acc0[r] * rstd; lg[n * 48 + 16 + 4 * kq + r] = acc1[r] * rstd; lg[n * 48 + 32 + 4 * kq + r] = acc2[r] * rstd; }
            LDS_WAIT(); asm volatile("" ::: "memory");
            int e1 = 0, e2 = 0, lp1 = 0, lp2 = 0; float w1 = 0.f, w2 = 0.f;
            if (lane < 16) {
                const LAS float* q = lg + lane * 48;
                float gl[4];
#pragma unroll
                for (int j = 0; j < 4; ++j) gl[j] = q[32 + j] + p_b_rg[j];
                int gi = 0; float gm = gl[0];
#pragma unroll
                for (int j = 1; j < 4; ++j) if (gl[j] > gm) { gm = gl[j]; gi = j; }
                float den = 0.f;
#pragma unroll
                for (int j = 0; j < 4; ++j) den += __expf(gl[j] - gm);
                const float pg = 1.0f / den;
                float el[8];
#pragma unroll
                for (int j = 0; j < 8; ++j) el[j] = q[8 * gi + j] + p_b_re[8 * gi + j];
                int i1 = 0; float v1 = el[0];
#pragma unroll
                for (int j = 1; j < 8; ++j) if (el[j] > v1) { v1 = el[j]; i1 = j; }
                int i2 = -1; float v2 = -3.0e38f;
#pragma unroll
                for (int j = 0; j < 8; ++j) if (j != i1 && el[j] > v2) { v2 = el[j]; i2 = j; }
                const float ex = __expf(v2 - v1); w1 = pg / (1.0f + ex); w2 = pg * ex / (1.0f + ex);
                e1 = 8 * gi + i1; e2 = 8 * gi + i2;
                lp1 = atomicAdd((int*)(hist + e1), 1); lp2 = atomicAdd((int*)(hist + e2), 1);
            }
            __syncthreads();
            if (tid < 32) { const int c = hist[tid]; int b = 0; if (c > 0) b = (int)__hip_atomic_fetch_add((unsigned*)(ctl + CW_CNT + 64 * tid), (unsigned)c, __ATOMIC_RELAXED, __HIP_MEMORY_SCOPE_AGENT); basee[tid] = b; }
            __syncthreads();
            if (lane < 16) { const int tok = tok0 + lane;
                const int i1 = e1 * CAP + basee[e1] + lp1, i2 = e2 * CAP + basee[e2] + lp2;
                TOKL[i1] = tok; SLOTL[i1] = 2 * tok; WL[i1] = w1; RSL[i1] = rstd;
                TOKL[i2] = tok; SLOTL[i2] = 2 * tok + 1; WL[i2] = w2; RSL[i2] = rstd; }
        }
    }
    }
    xcd_barrier(bar);

    LAS int* tb = (LAS int*)(L + TB_OFF);
    if (threadIdx.x == 0) { int acc = 0; for (int e = 0; e < NEXP; ++e) { tb[e] = acc; const unsigned c = __hip_atomic_load(ctl + CW_CNT + 64 * e, RLX_AGENT); acc += (int)((c + 255u) >> 8); } tb[NEXP] = acc; }
    __syncthreads();
    const int NT = __builtin_amdgcn_readfirstlane(tb[NEXP]);
    PH(9) {
        pg8::Gemm g{X28, W1, 0, DM, DM / 2}; pg8::MoeOrder S{tb, NT, G, vcu, TOKL, (size_t)2048 * 2048};
        pg8::EpiSwiglu E{RSL, (unsigned char*)HB, L};
        pg8::gemm_phase<pg8::EpiSwiglu, pg8::MoeOrder, true, true, 0, 0x79797979u>(L, g, S, E);
    }
    xcd_barrier(bar);
    PH(10) {
        pg8::Gemm g{HB, W2, 0, DM, 512}; pg8::MoeOrder S{tb, NT, G, vcu, nullptr, (size_t)2048 * 1024};
        pg8::EpiDown E{SLOTL, WL, (unsigned char*)YB, L};
        pg8::gemm_phase<pg8::EpiDown, pg8::MoeOrder, false, true, 0, 0x79797979u>(L, g, S, E);
    }
    xcd_barrier(bar);

    PH(11) {
    int tid11_ = threadIdx.x; asm volatile("" : "+v"(tid11_)); const int lane11_ = tid11_ & 63;
    for (int m = gw; m < T; m += NGW) {
        GAS f32x4* xr = (GAS f32x4*)(args.out + (size_t)m * DM) + lane11_;
        const GAS unsigned long long* x2 = (const GAS unsigned long long*)(X2B + (size_t)m * DM) + lane11_;
        const GAS unsigned* y0 = (const GAS unsigned*)((const unsigned char*)YB + (size_t)(2 * m) * DM) + lane11_; const GAS unsigned* y1 = (const GAS unsigned*)((const unsigned char*)YB + (size_t)(2 * m + 1) * DM) + lane11_;
        f32x4 v[8]; float s = 0.f;
#pragma unroll
        for (int j = 0; j < 8; ++j) { const unsigned long long c = x2[64 * j]; const int a = (int)y0[64 * j], b = (int)y1[64 * j];
            v[j].x = __uint_as_float((unsigned)c << 16) + (__builtin_amdgcn_cvt_f32_fp8(a, 0) + __builtin_amdgcn_cvt_f32_fp8(b, 0));
            v[j].y = __uint_as_float((unsigned)c & 0xffff0000u) + (__builtin_amdgcn_cvt_f32_fp8(a, 1) + __builtin_amdgcn_cvt_f32_fp8(b, 1));
            v[j].z = __uint_as_float((unsigned)(c >> 32) << 16) + (__builtin_amdgcn_cvt_f32_fp8(a, 2) + __builtin_amdgcn_cvt_f32_fp8(b, 2));
            v[j].w = __uint_as_float((unsigned)(c >> 32) & 0xffff0000u) + (__builtin_amdgcn_cvt_f32_fp8(a, 3) + __builtin_amdgcn_cvt_f32_fp8(b, 3));
            s += (v[j].x * v[j].x + v[j].y * v[j].y) + (v[j].z * v[j].z + v[j].w * v[j].w); }
        const float rstd = __builtin_amdgcn_rsqf(wave_sum(s) * (1.f / DM) + EPS);
        const GAS f32x4* gf = (const GAS f32x4*)p_g_final + lane11_;
#pragma unroll
        for (int j = 0; j < 8; ++j) { const f32x4 gg = gf[64 * j]; xr[64 * j] = v[j] * rstd * gg; }
    }
    }
}

extern "C" void kernel_launch(void* const* d_in, const int* in_sizes, int n_in, void* d_out, int out_size, void* d_ws, size_t ws_size, hipStream_t stream) {
    static int grid = 0;
    if (grid == 0) {
        if (n_in != 24 || in_sizes[0] != T * DM || out_size != T * DM || ws_size < WS_END) { fprintf(stderr, "kernel_launch: unexpected shapes (n_in %d, in0 %d, out %d, ws %zu); nothing launched\n", n_in, n_in > 0 ? in_sizes[0] : -1, out_size, ws_size); grid = -1; return; }
        int dev = 0, cus = 0, per_cu = 0;
        if (hipGetDevice(&dev) != hipSuccess || hipDeviceGetAttribute(&cus, hipDeviceAttributeMultiprocessorCount, dev) != hipSuccess) { fprintf(stderr, "kernel_launch: device query failed\n"); grid = -1; return; }
        if (hipFuncSetAttribute((const void*)fwd_kernel, hipFuncAttributeMaxDynamicSharedMemorySize, LDS_BYTES) != hipSuccess) { fprintf(stderr, "kernel_launch: hipFuncSetAttribute failed\n"); grid = -1; return; }
        if (hipOccupancyMaxActiveBlocksPerMultiprocessor(&per_cu, (const void*)fwd_kernel, NWAVES * 64, LDS_BYTES) != hipSuccess || per_cu < 1)
            fprintf(stderr, "kernel_launch: note: occupancy query reports %d workgroups per CU\n", per_cu);
        (void)hipGetLastError();
        grid = cus;
    }
    if (grid < 0) return;
    if (hipMemsetAsync((char*)d_ws + WS_CTL, 0, CTL_ZERO_BYTES, stream) != hipSuccess) { fprintf(stderr, "kernel_launch: memset failed\n"); return; }
    Args a{};
    for (int i = 0; i < 24; ++i) a.in[i] = (const float*)d_in[i];
    a.out = (float*)d_out; a.ws = (unsigned char*)d_ws;
    hipLaunchKernelGGL(fwd_kernel, dim3(grid), dim3(NWAVES * 64), LDS_BYTES, stream, a);
    const hipError_t le = hipPeekAtLastError();
    if (le != hipSuccess) fprintf(stderr, "kernel_launch: launch failed: %s\n", hipGetErrorName(le));
}
```
